# Optimizing an MI355X kernel written in HIP

```python
import jax, jax.numpy as jnp
from jax import lax
import numpy as np

D_MODEL = 2048
BATCH = 4
SEQ = 2048
DEPTH = 1

MEM_LEN = 256
D_CONV = D_MODEL // 2
CONV_WIDTH = 31
ATT_HEAD_DIM = 128
ATT_HEADS = (D_MODEL // 2) // ATT_HEAD_DIM
D_ATT = ATT_HEADS * ATT_HEAD_DIM
MOBA_BLOCK = 256
MOBA_TOPK = 3
Q_CHUNK = 16
CROSS_HEADS = 4
CROSS_HEAD_DIM = D_MODEL // CROSS_HEADS
D_FF = -(-(8 * D_MODEL) // (3 * 256)) * 256
IN_COLS = 2 * D_CONV + 3 * D_ATT + 2 * D_MODEL
EPS = 1e-6

kernel_name = "hybrid_gated_conformer_moba_block"


def rmsnorm(x, g):
    xf = x.astype(jnp.float32)
    y = xf * lax.rsqrt(jnp.mean(xf * xf, axis=-1, keepdims=True) + EPS)
    return (y * g.astype(jnp.float32)).astype(x.dtype)


def layernorm(x, g, b):
    xf = x.astype(jnp.float32)
    mu = jnp.mean(xf, axis=-1, keepdims=True)
    var = jnp.mean(jnp.square(xf - mu), axis=-1, keepdims=True)
    y = (xf - mu) * lax.rsqrt(var + EPS)
    return (y * g.astype(jnp.float32) + b.astype(jnp.float32)).astype(x.dtype)


def conformer_conv(u, conv_w, conv_b, ln_g, ln_b, w_proj):
    a, g = jnp.split(u, 2, axis=-1)
    v = a * jax.nn.sigmoid(g)
    y = lax.conv_general_dilated(
        v, conv_w[:, None, :].astype(v.dtype), window_strides=(1,),
        padding=[(CONV_WIDTH - 1, 0)],
        dimension_numbers=('NWC', 'WIO', 'NWC'),
        feature_group_count=D_CONV) + conv_b
    y = jax.nn.silu(layernorm(y, ln_g, ln_b))
    return y @ w_proj


def moba_attention(q, k, v):
    B, S, H, hd = q.shape
    n_blocks = -(-S // MOBA_BLOCK)
    s_pad = n_blocks * MOBA_BLOCK
    pad = [(0, 0), (0, 0), (0, s_pad - S), (0, 0)]
    qt = jnp.pad(jnp.transpose(q, (0, 2, 1, 3)), pad)
    kt = jnp.pad(jnp.transpose(k, (0, 2, 1, 3)), pad)
    vt = jnp.pad(jnp.transpose(v, (0, 2, 1, 3)), pad)
    kb = kt.reshape(B, H, n_blocks, MOBA_BLOCK, hd)
    vb = vt.reshape(B, H, n_blocks, MOBA_BLOCK, hd)
    scale = 1.0 / np.sqrt(hd)

    k_mean = jnp.mean(kb.astype(jnp.float32), axis=3)
    gate = jnp.einsum('bhsd,bhnd->bhsn', qt.astype(jnp.float32), k_mean)
    q_block = jnp.arange(s_pad) // MOBA_BLOCK
    past = jnp.arange(n_blocks)[None, :] < q_block[:, None]
    gate = jnp.where(past[None, None], gate, -jnp.inf)
    k_sel = min(MOBA_TOPK, n_blocks)
    _, sel = lax.top_k(gate, k_sel)
    sel_valid = jnp.arange(k_sel)[None, :] < q_block[:, None]

    n_chunks = s_pad // Q_CHUNK
    q_c = jnp.moveaxis(qt.reshape(B, H, n_chunks, Q_CHUNK, hd), 2, 0)
    sel_c = jnp.moveaxis(sel.reshape(B, H, n_chunks, Q_CHUNK, k_sel), 2, 0)
    valid_c = sel_valid.reshape(n_chunks, Q_CHUNK, k_sel)
    starts = jnp.arange(n_chunks, dtype=jnp.int32) * Q_CHUNK
    gather_blocks = jax.vmap(jax.vmap(lambda blocks, idx: blocks[idx]))

    def chunk(args):
        qc, selc, validc, start = args
        blk = start // MOBA_BLOCK
        k_own = lax.dynamic_index_in_dim(kb, blk, axis=2, keepdims=False)
        v_own = lax.dynamic_index_in_dim(vb, blk, axis=2, keepdims=False)
        k_past = gather_blocks(kb, selc)
        v_past = gather_blocks(vb, selc)
        s_past = jnp.einsum('bhcd,bhcjpd->bhcjp', qc, k_past,
                            preferred_element_type=jnp.float32) * scale
        s_own = jnp.einsum('bhcd,bhpd->bhcp', qc, k_own,
                           preferred_element_type=jnp.float32) * scale
        q_pos = start + jnp.arange(Q_CHUNK)
        k_pos = blk * MOBA_BLOCK + jnp.arange(MOBA_BLOCK)
        causal = k_pos[None, :] <= q_pos[:, None]
        s_past = jnp.where(validc[None, None, :, :, None], s_past, -jnp.inf)
        s_own = jnp.where(causal[None, None], s_own, -jnp.inf)
        logits = jnp.concatenate(
            [s_past.reshape(B, H, Q_CHUNK, k_sel * MOBA_BLOCK), s_own], axis=-1)
        p = jax.nn.softmax(logits, axis=-1)
        p_past = p[..., :k_sel * MOBA_BLOCK].reshape(B, H, Q_CHUNK, k_sel, MOBA_BLOCK)
        p_own = p[..., k_sel * MOBA_BLOCK:]
        out = (jnp.einsum('bhcjp,bhcjpd->bhcd', p_past.astype(v_past.dtype), v_past)
               + jnp.einsum('bhcp,bhpd->bhcd', p_own.astype(v_own.dtype), v_own))
        return out.astype(v.dtype)

    out = lax.map(chunk, (q_c, sel_c, valid_c, starts))
    out = jnp.moveaxis(out, 0, 2).reshape(B, H, s_pad, hd)[:, :, :S]
    return jnp.transpose(out, (0, 2, 1, 3)).reshape(B, S, H * hd)


def cross_attention(h, m, w_q, w_kv, w_o):
    B, S, _ = h.shape
    M = m.shape[1]
    q = (h @ w_q).reshape(B, S, CROSS_HEADS, CROSS_HEAD_DIM)
    k, v = jnp.split(m @ w_kv, 2, axis=-1)
    k = k.reshape(B, M, CROSS_HEADS, CROSS_HEAD_DIM)
    v = v.reshape(B, M, CROSS_HEADS, CROSS_HEAD_DIM)
    logits = jnp.einsum('bshd,bmhd->bhsm', q, k,
                        preferred_element_type=jnp.float32) / np.sqrt(CROSS_HEAD_DIM)
    p = jax.nn.softmax(logits, axis=-1).astype(v.dtype)
    out = jnp.einsum('bhsm,bmhd->bshd', p, v).reshape(B, S, D_MODEL)
    return out @ w_o


def swiglu(h, w_in, w_out):
    g, u = jnp.split(h @ w_in, 2, axis=-1)
    return (jax.nn.silu(g) * u) @ w_out


def setup_inputs(seed: int = 0) -> dict:
    key = jax.random.key(seed)
    ks = jax.random.split(key, 24)

    def w(k, shape, fan_in):
        return jax.random.normal(k, shape, jnp.float32) * (fan_in ** -0.5)

    def gain(k, shape):
        return 1.0 + 0.02 * jax.random.normal(k, shape, jnp.float32)

    def bias(k, shape):
        return 0.02 * jax.random.normal(k, shape, jnp.float32)

    L = DEPTH
    return {
        "x": jax.random.normal(ks[0], (BATCH, SEQ, D_MODEL), jnp.float32),
        "mem": jax.random.normal(ks[1], (BATCH, MEM_LEN, D_MODEL), jnp.float32),
        "norm_mix_g": gain(ks[2], (L, D_MODEL)),
        "w_in": w(ks[3], (L, D_MODEL, IN_COLS), D_MODEL),
        "b_in": bias(ks[4], (L, IN_COLS)),
        "conv_w": w(ks[5], (L, CONV_WIDTH, D_CONV), CONV_WIDTH),
        "conv_b": bias(ks[6], (L, D_CONV)),
        "conv_ln_g": gain(ks[7], (L, D_CONV)),
        "conv_ln_b": bias(ks[8], (L, D_CONV)),
        "w_conv_out": w(ks[9], (L, D_CONV, D_MODEL), D_CONV),
        "w_att_out": w(ks[10], (L, D_ATT, D_MODEL), D_ATT),
        "w_out": w(ks[11], (L, D_MODEL, D_MODEL), D_MODEL),
        "norm_cross_g": gain(ks[12], (L, D_MODEL)),
        "norm_mem_g": gain(ks[13], (L, D_MODEL)),
        "w_cq": w(ks[14], (L, D_MODEL, D_MODEL), D_MODEL),
        "w_ckv": w(ks[15], (L, D_MODEL, 2 * D_MODEL), D_MODEL),
        "w_co": w(ks[16], (L, D_MODEL, D_MODEL), D_MODEL),
        "norm_ffn_g": gain(ks[17], (L, D_MODEL)),
        "w_ffn_in": w(ks[18], (L, D_MODEL, 2 * D_FF), D_MODEL),
        "w_ffn_out": w(ks[19], (L, D_FF, D_MODEL), D_FF),
        "norm_final_g": gain(ks[20], (D_MODEL,)),
    }


def reference(x, mem, norm_mix_g, w_in, b_in, conv_w, conv_b, conv_ln_g, conv_ln_b,
              w_conv_out, w_att_out, w_out, norm_cross_g, norm_mem_g, w_cq, w_ckv,
              w_co, norm_ffn_g, w_ffn_in, w_ffn_out, norm_final_g):
    B, S, _ = x.shape
    split_at = [2 * D_CONV, 2 * D_CONV + D_ATT, 2 * D_CONV + 2 * D_ATT,
                2 * D_CONV + 3 * D_ATT, 2 * D_CONV + 3 * D_ATT + D_MODEL]
    for l in range(DEPTH):
        h = rmsnorm(x, norm_mix_g[l])
        proj = h @ w_in[l] + b_in[l]
        u_conv, q, k, v, g_conv, g_att = jnp.split(proj, split_at, axis=-1)
        y_conv = conformer_conv(u_conv, conv_w[l], conv_b[l], conv_ln_g[l],
                                conv_ln_b[l], w_conv_out[l])
        hs = (B, S, ATT_HEADS, ATT_HEAD_DIM)
        y_att = moba_attention(q.reshape(hs), k.reshape(hs), v.reshape(hs)) @ w_att_out[l]
        merged = jax.nn.sigmoid(g_conv) * y_conv + jax.nn.sigmoid(g_att) * y_att
        x = x + merged @ w_out[l]
        h = rmsnorm(x, norm_cross_g[l])
        m = rmsnorm(mem, norm_mem_g[l])
        x = x + cross_attention(h, m, w_cq[l], w_ckv[l], w_co[l])
        h = rmsnorm(x, norm_ffn_g[l])
        x = x + swiglu(h, w_ffn_in[l], w_ffn_out[l])
    return rmsnorm(x, norm_final_g)
```

```cpp
#include <hip/hip_runtime.h>
#include <hip/hip_cooperative_groups.h>
#include <cstdio>
#include <cstdint>
namespace cg = cooperative_groups;
namespace pg8 {
#define PG8_LAS __attribute__((address_space(3)))
typedef unsigned short bf16_t;
typedef short bf16x8 __attribute__((ext_vector_type(8)));
typedef float f32x4 __attribute__((ext_vector_type(4)));
typedef unsigned u32x4 __attribute__((ext_vector_type(4)));
constexpr int BM = 256, BK = 64, HALF = 128, HTB = HALF * BK * 2  , STAGE_BYTES = 8 * HTB, NXCD = 8, WGM = 8;

__host__ __device__ __forceinline__ int lds_byte(int r, int c) { const int st = (r >> 4) * 2 + (c >> 5), rr = r & 15, cc = c & 31, ob = rr * 64 + cc * 2; return st * 1024 + (ob ^ (((ob >> 9) & 1) << 5)); }
__host__ __device__ __forceinline__ void stage_rc(int b, int& R, int& C) { const int st = b / 1024, sb = b % 1024, swz = sb ^ (((sb >> 9) & 1) << 5); R = (st >> 1) * 16 + swz / 64; C = (st & 1) * 32 + (swz % 64) / 2; }
__host__ __device__ __forceinline__ int perm32(int rho) { const int n = rho >> 4, i = rho & 15; return 8 * (i >> 2) + 4 * n + (i & 3); }

struct Unit { int pm, pn; };
struct Gemm { const bf16_t* A; const bf16_t* Bt; int M, N, K; };

struct StaticOrder {
    int nM, nN, nwg, G, c;
    __host__ __device__ void init(int M, int N, int G_, int c_) { nM = M / BM; nN = N / BM; nwg = nM * nN; G = G_; c = c_; }
    __host__ __device__ bool next(int i, Unit& u) const {
        const long L = (long)i * G + c; if (L >= nwg) return false;
        int wgid = (int)L; { const int q = nwg / NXCD, r = nwg % NXCD, xcd = wgid % NXCD, off = wgid / NXCD; wgid = (xcd < r ? xcd * (q + 1) : r * (q + 1) + (xcd - r) * q) + off; }
        const int nig = WGM * nN, gid = wgid / nig, fm = gid * WGM, gsz = (nM - fm) < WGM ? (nM - fm) : WGM;
        u.pm = fm + ((wgid % nig) % gsz); u.pn = (wgid % nig) / gsz; return true;
    }
    __device__ __forceinline__ void a_ready(const Unit&) const {}
    __device__ __forceinline__ void done(const Unit&) const {}
};

__device__ __forceinline__ unsigned cvt_pk_bf16(float lo, float hi) { unsigned r; asm volatile("v_cvt_pk_bf16_f32 %0, %1, %2" : "=v"(r) : "v"(lo), "v"(hi)); return r; }
typedef float f32x2 __attribute__((ext_vector_type(2)));
__device__ __forceinline__ float sigm(float x) { return __builtin_amdgcn_rcpf(1.0f + __expf(-x)); }
__device__ __forceinline__ float bflo(unsigned w) { return __uint_as_float(w << 16); }
__device__ __forceinline__ float bfhi(unsigned w) { return __uint_as_float(w & 0xffff0000u); }
__device__ __forceinline__ u32x4 pack8(const f32x4 v0, const f32x4 v1) { u32x4 w; w.x = cvt_pk_bf16(v0[0], v0[1]); w.y = cvt_pk_bf16(v0[2], v0[3]); w.z = cvt_pk_bf16(v1[0], v1[1]); w.w = cvt_pk_bf16(v1[2], v1[3]); return w; }
constexpr float RMS_EPS = 1e-6f;

struct EpiProj {
    static constexpr bool PERM = true, AFTER_DRAIN = false;
    bf16_t *Vglu, *Q; size_t offK, offSG; const float* bias;
    __device__ __forceinline__ void operator()(const f32x4 (&acc)[2][2][4][2], const Unit& u, int wr, int wc, int fr, int fq) const {
        const int row0 = u.pm * BM + wr * 64 + fr, lc = wc * 32 + 8 * fq, bcol0 = u.pn * BM + lc;
        f32x4 bv[2][2];
#pragma unroll
        for (int bj = 0; bj < 2; ++bj)
#pragma unroll
            for (int n = 0; n < 2; ++n) bv[bj][n] = *(const f32x4*)(bias + bcol0 + bj * HALF + 4 * n);
        if (u.pn < 8) {
#pragma unroll
            for (int ai = 0; ai < 2; ++ai)
#pragma unroll
                for (int m = 0; m < 4; ++m) { bf16_t* rowp = Vglu + (size_t)(row0 + ai * HALF + m * 16) * 1024 + u.pn * 128 + lc;
                    f32x4 a0 = acc[ai][0][m][0] + bv[0][0], a1 = acc[ai][0][m][1] + bv[0][1], g0 = acc[ai][1][m][0] + bv[1][0], g1 = acc[ai][1][m][1] + bv[1][1];
#pragma unroll
                    for (int j = 0; j < 4; ++j) { a0[j] *= sigm(g0[j]); a1[j] *= sigm(g1[j]); }
                    *(u32x4*)rowp = pack8(a0, a1); }
        } else {
            const bool sg = u.pn >= 16; const int colt = sg ? (u.pn - 16) * 256 : ((u.pn - 8) & 3) * 256, ldc = sg ? 4096 : 1024;
            bf16_t* base = Q + (sg ? offSG : (u.pn >= 12 ? offK : (size_t)0));
#pragma unroll
            for (int ai = 0; ai < 2; ++ai)
#pragma unroll
                for (int m = 0; m < 4; ++m) { bf16_t* rowp = base + (size_t)(row0 + ai * HALF + m * 16) * ldc + colt + lc;
#pragma unroll
                    for (int bj = 0; bj < 2; ++bj) { f32x4 v0 = acc[ai][bj][m][0] + bv[bj][0], v1 = acc[ai][bj][m][1] + bv[bj][1];
                        if (sg) {
#pragma unroll
                            for (int j = 0; j < 4; ++j) { v0[j] = sigm(v0[j]); v1[j] = sigm(v1[j]); } }
                        *(u32x4*)(rowp + bj * HALF) = pack8(v0, v1); } }
        }
    }
};
struct EpiPlain {
    static constexpr bool PERM = true, AFTER_DRAIN = false;
    bf16_t* O; int ldc; const float* rowbias; int has_bias;
    __device__ __forceinline__ void operator()(const f32x4 (&acc)[2][2][4][2], const Unit& u, int wr, int wc, int fr, int fq) const {
        const int row0 = u.pm * BM + wr * 64 + fr, col0 = u.pn * BM + wc * 32 + 8 * fq;
#pragma unroll
        for (int ai = 0; ai < 2; ++ai)
#pragma unroll
            for (int m = 0; m < 4; ++m) { const int row = row0 + ai * HALF + m * 16; const float rb = has_bias ? rowbias[row] : 0.f; bf16_t* rowp = O + (size_t)row * ldc + col0;
#pragma unroll
                for (int bj = 0; bj < 2; ++bj) { f32x4 v0 = acc[ai][bj][m][0] + rb, v1 = acc[ai][bj][m][1] + rb; *(u32x4*)(rowp + bj * HALF) = pack8(v0, v1); } }
    }
};
template <bool SECOND> struct EpiGate {
    static constexpr bool PERM = true, AFTER_DRAIN = false;
    const bf16_t* SG; float* PART; bf16_t* MERGED;
    __device__ __forceinline__ void operator()(const f32x4 (&acc)[2][2][4][2], const Unit& u, int wr, int wc, int fr, int fq) const {
        const int row0 = u.pm * BM + wr * 64 + fr, col0 = u.pn * BM + wc * 32 + 8 * fq;
#pragma unroll
        for (int ai = 0; ai < 2; ++ai)
#pragma unroll
            for (int m = 0; m < 4; ++m) { const size_t row = (size_t)(row0 + ai * HALF + m * 16);
#pragma unroll
                for (int bj = 0; bj < 2; ++bj) { const int col = col0 + bj * HALF; const u32x4 gw = *(const u32x4*)(SG + row * 4096 + col);
                    f32x4 v0 = acc[ai][bj][m][0], v1 = acc[ai][bj][m][1];
                    v0[0] *= bflo(gw.x); v0[1] *= bfhi(gw.x); v0[2] *= bflo(gw.y); v0[3] *= bfhi(gw.y); v1[0] *= bflo(gw.z); v1[1] *= bfhi(gw.z); v1[2] *= bflo(gw.w); v1[3] *= bfhi(gw.w);
                    float* pp = PART + row * 2048 + col;
                    if (!SECOND) { *(f32x4*)pp = v0; *(f32x4*)(pp + 4) = v1; }
                    else { v0 += *(const f32x4*)pp; v1 += *(const f32x4*)(pp + 4); *(u32x4*)(MERGED + row * 2048 + col) = pack8(v0, v1); } } }
    }
};
template <bool WB> struct EpiResid {
    static constexpr bool PERM = true, AFTER_DRAIN = false;
    const float* resid; float* out; bf16_t* xb; float* ssq;
    __device__ __forceinline__ void operator()(const f32x4 (&acc)[2][2][4][2], const Unit& u, int wr, int wc, int fr, int fq) const {
        const int row0 = u.pm * BM + wr * 64 + fr, col0 = u.pn * BM + wc * 32 + 8 * fq;
#pragma unroll
        for (int ai = 0; ai < 2; ++ai)
#pragma unroll
            for (int m = 0; m < 4; ++m) { const size_t row = (size_t)(row0 + ai * HALF + m * 16); float sq = 0.f;
#pragma unroll
                for (int bj = 0; bj < 2; ++bj) { const size_t off = row * 2048 + col0 + bj * HALF;
                    const f32x4 v0 = acc[ai][bj][m][0] + *(const f32x4*)(resid + off), v1 = acc[ai][bj][m][1] + *(const f32x4*)(resid + off + 4);
                    *(f32x4*)(out + off) = v0; *(f32x4*)(out + off + 4) = v1;
                    sq += (v0[0] * v0[0] + v0[1] * v0[1]) + (v0[2] * v0[2] + v0[3] * v0[3]) + (v1[0] * v1[0] + v1[1] * v1[1]) + (v1[2] * v1[2] + v1[3] * v1[3]);
                    if (WB) *(u32x4*)(xb + off) = pack8(v0, v1); }
                sq += __shfl_xor(sq, 16); sq += __shfl_xor(sq, 32);
                if (fq == 0) ssq[row * 32 + u.pn * 4 + wc] = sq; }
    }
};
__device__ __forceinline__ float row_ssq(const float* ssq, size_t row, int fq) {
    const float* sp = ssq + row * 32 + fq * 8; const f32x4 a = *(const f32x4*)sp, b = *(const f32x4*)(sp + 4);
    float s = ((a[0] + a[1]) + (a[2] + a[3])) + ((b[0] + b[1]) + (b[2] + b[3]));
    s += __shfl_xor(s, 16); s += __shfl_xor(s, 32); return s;
}
struct EpiRowScale {
    static constexpr bool PERM = true, AFTER_DRAIN = false;
    bf16_t* O; const float* ssq; float mul;
    __device__ __forceinline__ void operator()(const f32x4 (&acc)[2][2][4][2], const Unit& u, int wr, int wc, int fr, int fq) const {
        const int row0 = u.pm * BM + wr * 64 + fr, col0 = u.pn * BM + wc * 32 + 8 * fq;
#pragma unroll
        for (int ai = 0; ai < 2; ++ai)
#pragma unroll
            for (int m = 0; m < 4; ++m) { const size_t row = (size_t)(row0 + ai * HALF + m * 16); const float rs = rsqrtf(row_ssq(ssq, row, fq) * (1.0f / 2048.0f) + RMS_EPS) * mul;
#pragma unroll
                for (int bj = 0; bj < 2; ++bj) *(u32x4*)(O + row * 2048 + col0 + bj * HALF) = pack8(acc[ai][bj][m][0] * rs, acc[ai][bj][m][1] * rs); }
    }
};
struct EpiSwiglu {
    static constexpr bool PERM = true, AFTER_DRAIN = false;
    bf16_t* ACT; const float* ssq;
    __device__ __forceinline__ void operator()(const f32x4 (&acc)[2][2][4][2], const Unit& u, int wr, int wc, int fr, int fq) const {
        const int row0 = u.pm * BM + wr * 64 + fr, lc = wc * 32 + 8 * fq;
#pragma unroll
        for (int ai = 0; ai < 2; ++ai)
#pragma unroll
            for (int m = 0; m < 4; ++m) { const size_t row = (size_t)(row0 + ai * HALF + m * 16); const float rs = rsqrtf(row_ssq(ssq, row, fq) * (1.0f / 2048.0f) + RMS_EPS);
                f32x4 g0 = acc[ai][0][m][0] * rs, g1 = acc[ai][0][m][1] * rs, u0 = acc[ai][1][m][0] * rs, u1 = acc[ai][1][m][1] * rs;
#pragma unroll
                for (int j = 0; j < 4; ++j) { g0[j] = g0[j] * sigm(g0[j]) * u0[j]; g1[j] = g1[j] * sigm(g1[j]) * u1[j]; }
                *(u32x4*)(ACT + row * 5632 + u.pn * 128 + lc) = pack8(g0, g1); }
    }
};

template <class Epi, class Sched, bool ALIGN_EPI = false, bool SP2 = false>
__device__ __forceinline__ void gemm_phase(PG8_LAS unsigned char* lds, const Gemm g, const Sched& S, const Epi& E) {
    const int tid = threadIdx.x, wid = __builtin_amdgcn_readfirstlane(tid >> 6), lane = tid & 63, wr = wid >> 2, wc = wid & 3, fr = lane & 15, fq = lane >> 4;
    const int K = g.K, nt = K / BK;
    unsigned voffA[2], voffB[2];
#pragma unroll
    for (int i = 0; i < 2; ++i) { int R, C; stage_rc(tid * 16 + i * 8192, R, C); const int Rb = Epi::PERM ? ((R & ~31) + perm32(R & 31)) : R;
        voffA[i] = (unsigned)(R * K + C) * 2u; voffB[i] = (unsigned)(Rb * K + C) * 2u; }
    const size_t kstep = (size_t)(BK * 2);
    const size_t hstep = (size_t)HALF * K * 2;
    const size_t tstep = 2 * hstep;
    const unsigned ldsw = (unsigned)wid * 1024u;
    const int aoff = lds_byte(wr * 64 + fr, fq * 8), boff = lds_byte(wc * 32 + fr, fq * 8);
#define PG8_SA(b, h) (((b) * 2 + (h)) * HTB)
#define PG8_SB(b, h) ((4 + (b) * 2 + (h)) * HTB)
#define PG8_STAGE(bufoff, gbase, voff) do { _Pragma("unroll") for (int _i = 0; _i < 2; ++_i) \
        __builtin_amdgcn_global_load_lds((const unsigned*)((const char*)(gbase) + (voff)[_i]), (PG8_LAS unsigned*)(lds + (bufoff) + ldsw + _i * 8192), 16, 0, 0); } while (0)
#define PG8_LDA(dst, b, h) do { _Pragma("unroll") for (int m = 0; m < 4; ++m) _Pragma("unroll") for (int k = 0; k < 2; ++k) dst[m][k] = *(const PG8_LAS bf16x8*)(lds + PG8_SA(b, h) + aoff + m * 2048 + k * 1024); } while (0)
#define PG8_LDB(dst, b, h) do { _Pragma("unroll") for (int n = 0; n < 2; ++n) _Pragma("unroll") for (int k = 0; k < 2; ++k) dst[n][k] = *(const PG8_LAS bf16x8*)(lds + PG8_SB(b, h) + boff + n * 2048 + k * 1024); } while (0)
#define PG8_MMA(ai, bj, At, Bt) do { __builtin_amdgcn_s_setprio(1); _Pragma("unroll") for (int m = 0; m < 4; ++m) _Pragma("unroll") for (int n = 0; n < 2; ++n) _Pragma("unroll") for (int k = 0; k < 2; ++k) \
        acc[ai][bj][m][n] = __builtin_amdgcn_mfma_f32_16x16x32_bf16(Bt[n][k], At[m][k], acc[ai][bj][m][n], 0, 0, 0); __builtin_amdgcn_s_setprio(0); } while (0)
#define PG8_WAIT_V(n) asm volatile("s_waitcnt vmcnt(" #n ")" ::: "memory")
#define PG8_WAIT_L(n) asm volatile("s_waitcnt lgkmcnt(" #n ")" ::: "memory")
#define PG8_BAR __builtin_amdgcn_s_barrier()
#define PG8_SCHED __builtin_amdgcn_sched_barrier(0)
    Unit cur, nxt; int ui = 0;
    if (!S.next(0, cur)) return;
    f32x4 acc[2][2][4][2];
#pragma unroll
    for (int a = 0; a < 2; ++a)
#pragma unroll
        for (int b = 0; b < 2; ++b)
#pragma unroll
            for (int m = 0; m < 4; ++m)
#pragma unroll
                for (int n = 0; n < 2; ++n) acc[a][b][m][n] = (f32x4){0.f, 0.f, 0.f, 0.f};
    bf16x8 At[4][2], B0[2][2], B1[2][2];
    const char* cA = (const char*)g.A + (size_t)cur.pm * tstep; const char* cB = (const char*)g.Bt + (size_t)cur.pn * tstep;
    S.a_ready(cur);
    if constexpr (SP2) {
        PG8_STAGE(PG8_SB(0, 0), cB, voffB); PG8_STAGE(PG8_SB(0, 1), cB + hstep, voffB); PG8_STAGE(PG8_SA(0, 0), cA, voffA); PG8_STAGE(PG8_SA(0, 1), cA + hstep, voffA);
        if (wr == 1) PG8_BAR;
        PG8_WAIT_V(2); PG8_BAR;
        PG8_STAGE(PG8_SB(1, 0), cB + kstep, voffB); PG8_STAGE(PG8_SA(1, 0), cA + kstep, voffA); PG8_STAGE(PG8_SB(1, 1), cB + hstep + kstep, voffB);
        PG8_WAIT_V(6); PG8_BAR;
    } else {
        PG8_STAGE(PG8_SB(0, 0), cB, voffB); PG8_STAGE(PG8_SA(0, 0), cA, voffA); PG8_STAGE(PG8_SB(0, 1), cB + hstep, voffB); PG8_STAGE(PG8_SA(0, 1), cA + hstep, voffA);
        if (wr == 1) PG8_BAR;
        PG8_WAIT_V(4); PG8_BAR;
        PG8_STAGE(PG8_SB(1, 0), cB + kstep, voffB); PG8_STAGE(PG8_SA(1, 0), cA + kstep, voffA); PG8_STAGE(PG8_SB(1, 1), cB + hstep + kstep, voffB);
        PG8_WAIT_V(6); PG8_BAR;
    }
    for (;;) {
        const bool has_next = S.next(ui + 1, nxt);
        const char* nA = has_next ? (const char*)g.A + (size_t)nxt.pm * tstep : cA; const char* nB = has_next ? (const char*)g.Bt + (size_t)nxt.pn * tstep : cB;
        for (int t = 0; t < nt; t += 2) {
            const bool last = (t == nt - 2);
            const char* a1 = cA + (size_t)(t + 1) * kstep;
            const char* a2 = last ? nA : cA + (size_t)(t + 2) * kstep; const char* b2 = last ? nB : cB + (size_t)(t + 2) * kstep;
            const char* a3 = a2 + kstep; const char* b3 = b2 + kstep;
            if (last && has_next) S.a_ready(nxt);
            if constexpr (SP2) {
            PG8_LDB(B0, 0, 0); PG8_LDB(B1, 0, 1); PG8_SCHED; PG8_LDA(At, 0, 0); PG8_STAGE(PG8_SA(1, 1), a1 + hstep, voffA);
            PG8_WAIT_V(8); PG8_WAIT_L(0); PG8_BAR; PG8_MMA(0, 0, At, B0); PG8_MMA(0, 1, At, B1); PG8_BAR; PG8_SCHED;
            PG8_LDA(At, 0, 1); PG8_STAGE(PG8_SB(0, 0), b2, voffB); PG8_STAGE(PG8_SB(0, 1), b2 + hstep, voffB); PG8_STAGE(PG8_SA(0, 0), a2, voffA);
            PG8_WAIT_V(8); PG8_WAIT_L(0); PG8_BAR; PG8_MMA(1, 0, At, B0); PG8_MMA(1, 1, At, B1); PG8_BAR; PG8_SCHED;
            PG8_LDB(B0, 1, 0); PG8_LDB(B1, 1, 1); PG8_SCHED; PG8_LDA(At, 1, 0); PG8_STAGE(PG8_SA(0, 1), a2 + hstep, voffA);
            PG8_WAIT_V(8); PG8_WAIT_L(0); PG8_BAR; PG8_MMA(0, 0, At, B0); PG8_MMA(0, 1, At, B1); PG8_BAR; PG8_SCHED;
            PG8_LDA(At, 1, 1); PG8_STAGE(PG8_SB(1, 0), b3, voffB); PG8_STAGE(PG8_SB(1, 1), b3 + hstep, voffB); PG8_STAGE(PG8_SA(1, 0), a3, voffA);
            PG8_WAIT_V(8); PG8_WAIT_L(0); PG8_BAR; PG8_MMA(1, 0, At, B0); PG8_MMA(1, 1, At, B1); PG8_BAR; PG8_SCHED;
            } else {
            PG8_LDB(B0, 0, 0); PG8_SCHED; PG8_LDA(At, 0, 0); PG8_STAGE(PG8_SA(1, 1), a1 + hstep, voffA);
            PG8_WAIT_L(8); PG8_BAR; PG8_WAIT_L(0); PG8_MMA(0, 0, At, B0); PG8_BAR; PG8_SCHED;
            PG8_LDB(B1, 0, 1); PG8_STAGE(PG8_SB(0, 0), b2, voffB);
            PG8_BAR; PG8_WAIT_L(0); PG8_MMA(0, 1, At, B1); PG8_BAR;
            PG8_LDA(At, 0, 1); PG8_STAGE(PG8_SA(0, 0), a2, voffA);
            PG8_BAR; PG8_WAIT_L(0); PG8_MMA(1, 0, At, B0); PG8_BAR; PG8_SCHED;
            PG8_STAGE(PG8_SB(0, 1), b2 + hstep, voffB);
            PG8_WAIT_V(6); PG8_BAR; PG8_MMA(1, 1, At, B1); PG8_BAR;
            PG8_LDB(B0, 1, 0); PG8_SCHED; PG8_LDA(At, 1, 0); PG8_STAGE(PG8_SA(0, 1), a2 + hstep, voffA);
            PG8_WAIT_L(8); PG8_BAR; PG8_WAIT_L(0); PG8_MMA(0, 0, At, B0); PG8_BAR; PG8_SCHED;
            PG8_LDB(B1, 1, 1); PG8_STAGE(PG8_SB(1, 0), b3, voffB);
            PG8_BAR; PG8_WAIT_L(0); PG8_MMA(0, 1, At, B1); PG8_BAR;
            PG8_LDA(At, 1, 1); PG8_STAGE(PG8_SA(1, 0), a3, voffA);
            PG8_BAR; PG8_WAIT_L(0); PG8_MMA(1, 0, At, B0); PG8_BAR; PG8_SCHED;
            PG8_STAGE(PG8_SB(1, 1), b3 + hstep, voffB);
            PG8_WAIT_V(6); PG8_BAR; PG8_MMA(1, 1, At, B1); PG8_BAR;
            }
        }
        if constexpr (ALIGN_EPI) { if (wr == 0) PG8_BAR; }
        if constexpr (!Epi::AFTER_DRAIN) { E(acc, cur, wr, wc, fr, fq); S.done(cur); }
        if (!has_next) break;
#pragma unroll
        for (int a = 0; a < 2; ++a)
#pragma unroll
            for (int b = 0; b < 2; ++b)
#pragma unroll
                for (int m = 0; m < 4; ++m)
#pragma unroll
                    for (int n = 0; n < 2; ++n) acc[a][b][m][n] = (f32x4){0.f, 0.f, 0.f, 0.f};
        cur = nxt; cA = nA; cB = nB; ++ui;
        if constexpr (ALIGN_EPI) { if (wr == 1) PG8_BAR; }
    }
    PG8_WAIT_V(0);
    if constexpr (!ALIGN_EPI) { if (wr == 0) PG8_BAR; }
    PG8_BAR;
    if constexpr (Epi::AFTER_DRAIN) { E.fused(acc, cur, wr, wc, fr, fq, lds, wid, lane); S.done(cur); }
#undef PG8_SA
#undef PG8_SB
#undef PG8_STAGE
#undef PG8_LDA
#undef PG8_LDB
#undef PG8_MMA
#undef PG8_WAIT_V
#undef PG8_WAIT_L
#undef PG8_BAR
#undef PG8_SCHED
}
}

#define LAS __attribute__((address_space(3)))
typedef unsigned short bf16_t;
typedef float f32x4 __attribute__((ext_vector_type(4)));
typedef float f32x2v __attribute__((ext_vector_type(2)));
typedef unsigned u32x4 __attribute__((ext_vector_type(4)));
typedef unsigned u32x2 __attribute__((ext_vector_type(2)));
typedef short bf16x8 __attribute__((ext_vector_type(8)));
using pg8::bflo; using pg8::bfhi; using pg8::cvt_pk_bf16; using pg8::sigm;

#ifndef MK_SPLIT
#define MK_SPLIT 0
#endif
constexpr int NPHASE = 11;
constexpr int T = 8192, D = 2048, SEQ = 2048, NB = 4, DC = 1024, DA = 1024, DFF = 5632, MEMT = 1024;
constexpr float EPS = 1e-6f;
constexpr int LDS_BYTES = 139264;
constexpr size_t MiB = 1u << 20;
constexpr size_t WS_CTL = 0;
constexpr size_t WS_SSQ = 151 * MiB;
constexpr size_t WS_WIN = 1 * MiB;
constexpr size_t WS_WCKV = 37 * MiB;
constexpr size_t WS_WCONV = 53 * MiB;
constexpr size_t WS_WATT = 57 * MiB;
constexpr size_t WS_WOUT = 61 * MiB;
constexpr size_t WS_WCQ = 69 * MiB;
constexpr size_t WS_WCO = 77 * MiB;
constexpr size_t WS_WFI = 85 * MiB;
constexpr size_t WS_WFO = 129 * MiB;
constexpr size_t WS_H = 152 * MiB;
constexpr size_t WS_MN = 184 * MiB;
constexpr size_t WS_VGLU = 188 * MiB;
constexpr size_t WS_Q = 204 * MiB, WS_K = 220 * MiB, WS_VT = 236 * MiB;
constexpr size_t WS_SG = 252 * MiB;
constexpr size_t WS_KC = 316 * MiB, WS_VCT = 320 * MiB;
constexpr size_t WS_YC = 324 * MiB, WS_YA = 340 * MiB;
constexpr size_t WS_PART = 152 * MiB;
constexpr size_t WS_MERGED = 216 * MiB;
constexpr size_t WS_X1B = 1 * MiB;
constexpr size_t WS_QC = 152 * MiB;
constexpr size_t WS_OC = 184 * MiB;
constexpr size_t WS_X2B = 216 * MiB;
constexpr size_t WS_ACT = 252 * MiB;
constexpr size_t WS_END = 356 * MiB;

struct Args { const float* in[21]; float* out; unsigned char* ws; int lo, hi; };

__device__ __forceinline__ float wave_sum(float v) {
#pragma unroll
    for (int o = 1; o < 64; o <<= 1) v += __shfl_xor(v, o);
    return v;
}
#define LDS_WAIT() asm volatile("s_waitcnt lgkmcnt(0)" ::: "memory")

__device__ __forceinline__ int map_win(int n) {
    if (n < 2048) { const int bj = n >> 10, c = n & 1023; return (c >> 7) * 256 + bj * 128 + (c & 127); }
    if (n < 4096) return n;
    if (n < 5120) return 8192 + (n - 4096);
    return n - 1024;
}
__device__ __forceinline__ int map_ffn(int n) { const int bj = n >= DFF ? 1 : 0, c = n - bj * DFF; return (c >> 7) * 256 + bj * 128 + (c & 127); }
__device__ __forceinline__ void tr_item(const float* W, int K, int N, bf16_t* WT, int mode, const float* gain, LAS float* scr, int item, int lane) {
    const int nblk = N >> 6, kb = item / nblk, nb = item - kb * nblk, k0 = kb * 64, n0 = nb * 64;
    const int c16 = lane & 15, r4 = lane >> 4;
#pragma unroll 4
    for (int i = 0; i < 16; ++i) { const int kk = 4 * i + r4; const f32x4 v = *(const f32x4*)(W + (size_t)(k0 + kk) * N + n0 + 4 * c16);
        LAS float* s = scr + kk * 65 + 4 * c16; s[0] = v[0]; s[1] = v[1]; s[2] = v[2]; s[3] = v[3]; }
    LDS_WAIT();
    const int c = lane & 7;
    float gk[8];
#pragma unroll
    for (int i = 0; i < 8; ++i) gk[i] = gain ? gain[k0 + 8 * c + i] : 1.0f;
#pragma unroll
    for (int j = 0; j < 8; ++j) { const int n = (lane >> 3) + 8 * j; const LAS float* s = scr + (8 * c) * 65 + n;
        u32x4 o; o.x = cvt_pk_bf16(s[0] * gk[0], s[65] * gk[1]); o.y = cvt_pk_bf16(s[130] * gk[2], s[195] * gk[3]); o.z = cvt_pk_bf16(s[260] * gk[4], s[325] * gk[5]); o.w = cvt_pk_bf16(s[390] * gk[6], s[455] * gk[7]);
        const int nn = n0 + n; const int dr = mode == 1 ? map_win(nn) : (mode == 2 ? map_ffn(nn) : nn);
        *(u32x4*)(WT + (size_t)dr * K + k0 + 8 * c) = o; }
    LDS_WAIT();
}
__device__ __forceinline__ void rms_row_bf16(const float* xrow, const float* g, bf16_t* orow, int lane) {
    const f32x4* xr = (const f32x4*)xrow + lane; f32x4 v[8]; float s = 0.f;
#pragma unroll
    for (int j = 0; j < 8; ++j) { v[j] = xr[64 * j]; s += (v[j][0] * v[j][0] + v[j][1] * v[j][1]) + (v[j][2] * v[j][2] + v[j][3] * v[j][3]); }
    const float rstd = rsqrtf(wave_sum(s) * (1.0f / 2048.0f) + EPS);
    u32x2* o8 = (u32x2*)orow + lane;
#pragma unroll
    for (int j = 0; j < 8; ++j) { const f32x4 gg = ((const f32x4*)g)[64 * j + lane]; u32x2 w; w.x = cvt_pk_bf16(v[j][0] * rstd * gg[0], v[j][1] * rstd * gg[1]); w.y = cvt_pk_bf16(v[j][2] * rstd * gg[2], v[j][3] * rstd * gg[3]); o8[64 * j] = w; }
}

__device__ __forceinline__ void conv_unit(LAS unsigned char* lds, int tile, const bf16_t* Vglu, const float* conv_w, const float* conv_b, const float* ln_g, const float* ln_b, bf16_t* YC, int tid, int wave, int lane) {
    constexpr int TT = 16;
    const int t0 = tile * TT, tb = t0 & (SEQ - 1), c0 = 2 * tid;
    float w0[31], w1[31];
#pragma unroll
    for (int j = 0; j < 31; ++j) { const f32x2v w = *(const f32x2v*)(conv_w + j * DC + c0); w0[j] = w[0]; w1[j] = w[1]; }
    const f32x2v bb = *(const f32x2v*)(conv_b + c0);
    float a0[TT], a1[TT];
#pragma unroll
    for (int t = 0; t < TT; ++t) { a0[t] = bb[0]; a1[t] = bb[1]; }
#pragma unroll
    for (int r = -30; r < TT; ++r) {
        const bool ok = (tb + r) >= 0;
        unsigned w = *(const unsigned*)(Vglu + (size_t)(ok ? t0 + r : t0) * DC + c0);
        w = ok ? w : 0u;
        const float v0 = bflo(w), v1 = bfhi(w);
#pragma unroll
        for (int t = 0; t < TT; ++t) { const int j = r - t + 30; if (j >= 0 && j <= 30) { a0[t] += w0[j] * v0; a1[t] += w1[j] * v1; } }
    }
    LAS float* red = (LAS float*)lds;
    LAS float* stat = (LAS float*)(lds + 65536);
    __syncthreads();
#pragma unroll
    for (int t = 0; t < TT; ++t) { red[(2 * t) * 512 + tid] = a0[t] + a1[t]; red[(2 * t + 1) * 512 + tid] = a0[t] * a0[t] + a1[t] * a1[t]; }
    __syncthreads();
#pragma unroll
    for (int q = 0; q < 4; ++q) { const int st = wave * 4 + q; float s = 0.f;
#pragma unroll
        for (int i = 0; i < 8; ++i) s += red[st * 512 + lane + 64 * i];
        s = wave_sum(s); if (lane == 0) stat[st] = s; }
    __syncthreads();
    const f32x2v lg = *(const f32x2v*)(ln_g + c0), lb = *(const f32x2v*)(ln_b + c0);
#pragma unroll
    for (int t = 0; t < TT; ++t) { const float mean = stat[2 * t] * (1.0f / DC), var = stat[2 * t + 1] * (1.0f / DC) - mean * mean, rstd = rsqrtf(fmaxf(var, 0.f) + EPS);
        const float z0 = (a0[t] - mean) * rstd * lg[0] + lb[0], z1 = (a1[t] - mean) * rstd * lg[1] + lb[1];
        *(unsigned*)(YC + (size_t)(t0 + t) * DC + c0) = cvt_pk_bf16(z0 * sigm(z0), z1 * sigm(z1)); }
}

__device__ __forceinline__ bf16_t f2bf_sw(float f) { const unsigned u = __float_as_uint(f); return (bf16_t)((u + 0x7fffu + ((u >> 16) & 1u)) >> 16); }
__device__ __forceinline__ f32x4 mfma16(bf16x8 a, bf16x8 b, f32x4 c) { return __builtin_amdgcn_mfma_f32_16x16x32_bf16(a, b, c, 0, 0, 0); }
__device__ __forceinline__ void moba_unit(LAS unsigned char* lds, int b, int h, int qt, const bf16_t* Q, const bf16_t* K, const bf16_t* Vt, bf16_t* YA, int tid, int wave, int lane) {
    const int qb = qt >> 1, half = qt & 1, r16 = lane & 15, g = lane >> 4;
    LAS unsigned char* Ks = lds;
    LAS unsigned char* Vs = lds + 17408;
    LAS unsigned char* Ps = lds + 35840 + wave * 2304;
    LAS float* kmean = (LAS float*)(lds + 54272);
    LAS float* gate = (LAS float*)(lds + 58368);
    LAS unsigned* selm = (LAS unsigned*)(lds + 62464);
    LAS float* red = (LAS float*)(lds + 62976);
    const size_t tok0 = (size_t)b * SEQ;
    const int q0 = qb * 256 + half * 128;
    __syncthreads();
    if (qb > 0) {
        for (int j = 0; j < qb; ++j) {
            const int dp = tid & 63, rg = tid >> 6; float s0 = 0.f, s1 = 0.f;
            const bf16_t* kp = K + (tok0 + j * 256 + rg * 32) * DA + h * 128 + 2 * dp;
#pragma unroll 8
            for (int r = 0; r < 32; ++r) { const unsigned w = *(const unsigned*)(kp + (size_t)r * DA); s0 += bflo(w); s1 += bfhi(w); }
            red[rg * 128 + 2 * dp] = s0; red[rg * 128 + 2 * dp + 1] = s1;
            __syncthreads();
            if (tid < 128) { float s = 0.f;
#pragma unroll
                for (int r2 = 0; r2 < 8; ++r2) s += red[r2 * 128 + tid];
                kmean[j * 128 + tid] = s * (1.0f / 256.0f); }
            __syncthreads();
        }
        { const int q = tid & 127, jg = tid >> 7; const bf16_t* qp = Q + (tok0 + q0 + q) * DA + h * 128; float d0 = 0.f, d1 = 0.f;
            const LAS float* km0 = kmean + jg * 128; const LAS float* km1 = kmean + (jg + 4) * 128;
#pragma unroll 4
            for (int c = 0; c < 16; ++c) { const u32x4 w = *(const u32x4*)(qp + 8 * c); const float qv[8] = {bflo(w.x), bfhi(w.x), bflo(w.y), bfhi(w.y), bflo(w.z), bfhi(w.z), bflo(w.w), bfhi(w.w)};
#pragma unroll
                for (int i = 0; i < 8; ++i) { d0 += qv[i] * km0[8 * c + i]; d1 += qv[i] * km1[8 * c + i]; } }
            if (jg < qb) gate[q * 8 + jg] = d0;
            if (jg + 4 < qb) gate[q * 8 + jg + 4] = d1; }
        __syncthreads();
        if (tid < 128) { float gv[8];
#pragma unroll
            for (int j = 0; j < 8; ++j) gv[j] = (j < qb) ? gate[tid * 8 + j] : -__builtin_inff();
            unsigned mask = 0u; const int nsel = qb < 3 ? qb : 3;
#pragma unroll
            for (int s = 0; s < 3; ++s) if (s < nsel) { int best = -1; float bvv = 0.f;
#pragma unroll
                for (int j = 0; j < 8; ++j) { const bool cand = (j < qb) && !((mask >> j) & 1u); if (cand && (best < 0 || gv[j] > bvv)) { best = j; bvv = gv[j]; } }
                mask |= 1u << best; }
            selm[tid] = mask; }
        __syncthreads();
    }
    bf16x8 qf[4];
    { const bf16_t* qp = Q + (tok0 + q0 + wave * 16 + r16) * DA + h * 128 + 8 * g;
#pragma unroll
        for (int ks = 0; ks < 4; ++ks) qf[ks] = *(const bf16x8*)(qp + 32 * ks); }
    unsigned sm[4];
#pragma unroll
    for (int r = 0; r < 4; ++r) sm[r] = qb > 0 ? selm[wave * 16 + 4 * g + r] : 0u;
    f32x4 o[8];
#pragma unroll
    for (int d = 0; d < 8; ++d) o[d] = (f32x4){0.f, 0.f, 0.f, 0.f};
    float mrow[4] = {-1e30f, -1e30f, -1e30f, -1e30f}, lrow[4] = {0.f, 0.f, 0.f, 0.f};
    const int n_own = half ? 4 : 2, ntiles = n_own + 4 * qb;
    const float scale = 0.08838834764831845f;
    for (int it = 0; it < ntiles; ++it) {
        const bool own = it < n_own; const int blk = own ? qb : ((it - n_own) >> 2), kt = own ? it : ((it - n_own) & 3);
        const int key0 = blk * 256 + kt * 64;
        __syncthreads();
#pragma unroll
        for (int i = 0; i < 2; ++i) { const int idx = tid + 512 * i, row = idx >> 4, c = idx & 15;
            const u32x4 w = *(const u32x4*)(K + (tok0 + key0 + row) * DA + h * 128 + 8 * c); *(LAS u32x4*)(Ks + row * 272 + c * 16) = w; }
#pragma unroll
        for (int i = 0; i < 2; ++i) { const int idx = tid + 512 * i, d = idx >> 3, c = idx & 7;
            const u32x4 w = *(const u32x4*)(Vt + (size_t)(h * 128 + d) * T + tok0 + key0 + 8 * c); *(LAS u32x4*)(Vs + d * 144 + c * 16) = w; }
        __syncthreads();
        f32x4 s[4];
#pragma unroll
        for (int sub = 0; sub < 4; ++sub) { s[sub] = (f32x4){0.f, 0.f, 0.f, 0.f};
#pragma unroll
            for (int ks = 0; ks < 4; ++ks) { const bf16x8 kb = *(const LAS bf16x8*)(Ks + (16 * sub + r16) * 272 + 64 * ks + 16 * g); s[sub] = mfma16(qf[ks], kb, s[sub]); } }
#pragma unroll
        for (int r = 0; r < 4; ++r) {
            const int qpos = q0 + wave * 16 + 4 * g + r; float mx = -1e30f;
#pragma unroll
            for (int sub = 0; sub < 4; ++sub) { const int kpos = key0 + 16 * sub + r16; const bool valid = own ? (kpos <= qpos) : (((sm[r] >> blk) & 1u) != 0u);
                const float v = valid ? s[sub][r] * scale : -1e30f; s[sub][r] = v; mx = fmaxf(mx, v); }
#pragma unroll
            for (int off = 1; off < 16; off <<= 1) mx = fmaxf(mx, __shfl_xor(mx, off));
            const float mnew = fmaxf(mrow[r], mx), alpha = __expf(mrow[r] - mnew); mrow[r] = mnew; float ps = 0.f;
#pragma unroll
            for (int sub = 0; sub < 4; ++sub) { const float p = (s[sub][r] > -1e29f) ? __expf(s[sub][r] - mnew) : 0.f; ps += p;
                *(LAS unsigned short*)(Ps + (4 * g + r) * 144 + (16 * sub + r16) * 2) = (unsigned short)(cvt_pk_bf16(p, 0.f) & 0xffffu); }
            lrow[r] = lrow[r] * alpha + ps;
#pragma unroll
            for (int d = 0; d < 8; ++d) o[d][r] *= alpha;
        }
        LDS_WAIT();
#pragma unroll
        for (int ks2 = 0; ks2 < 2; ++ks2) { const bf16x8 pa = *(const LAS bf16x8*)(Ps + r16 * 144 + 64 * ks2 + 16 * g);
#pragma unroll
            for (int d = 0; d < 8; ++d) { const bf16x8 vb = *(const LAS bf16x8*)(Vs + (16 * d + r16) * 144 + 64 * ks2 + 16 * g); o[d] = mfma16(pa, vb, o[d]); } }
    }
#pragma unroll
    for (int r = 0; r < 4; ++r) { float l = lrow[r];
#pragma unroll
        for (int off = 1; off < 16; off <<= 1) l += __shfl_xor(l, off);
        const float inv = 1.0f / l; bf16_t* op = YA + (tok0 + q0 + wave * 16 + 4 * g + r) * DA + h * 128 + r16;
#pragma unroll
        for (int d = 0; d < 8; ++d) op[16 * d] = f2bf_sw(o[d][r] * inv); }
}

__device__ __forceinline__ void cross_unit(LAS unsigned char* lds, int b, int hd, int qt, const bf16_t* QC, const bf16_t* KC, const bf16_t* VCt, bf16_t* OC, int tid, int wave, int lane) {
    const int r16 = lane & 15, g = lane >> 4;
    LAS unsigned char* RA = lds;
    LAS unsigned char* Pc = lds + 67584 + wave * 8448;
    const size_t tokq = (size_t)b * SEQ + qt * 128 + wave * 16;
    bf16x8 qf[16];
    { const bf16_t* qp = QC + (tokq + r16) * D + hd * 512 + 8 * g;
#pragma unroll
        for (int ks = 0; ks < 16; ++ks) qf[ks] = *(const bf16x8*)(qp + 32 * ks); }
    f32x4 s[16];
#pragma unroll
    for (int kt = 0; kt < 4; ++kt) {
        __syncthreads();
#pragma unroll
        for (int i = 0; i < 8; ++i) { const int idx = tid + 512 * i, row = idx >> 6, c = idx & 63;
            const u32x4 w = *(const u32x4*)(KC + (size_t)(b * 256 + 64 * kt + row) * D + hd * 512 + 8 * c); *(LAS u32x4*)(RA + row * 1040 + c * 16) = w; }
        __syncthreads();
#pragma unroll
        for (int sub = 0; sub < 4; ++sub) { f32x4 a = (f32x4){0.f, 0.f, 0.f, 0.f};
#pragma unroll
            for (int ks = 0; ks < 16; ++ks) { const bf16x8 kb = *(const LAS bf16x8*)(RA + (16 * sub + r16) * 1040 + 64 * ks + 16 * g); a = mfma16(qf[ks], kb, a); }
            s[4 * kt + sub] = a; }
    }
#pragma unroll
    for (int r = 0; r < 4; ++r) { float mx = -1e30f;
#pragma unroll
        for (int t = 0; t < 16; ++t) mx = fmaxf(mx, s[t][r]);
#pragma unroll
        for (int off = 1; off < 16; off <<= 1) mx = fmaxf(mx, __shfl_xor(mx, off));
        float ps = 0.f;
#pragma unroll
        for (int t = 0; t < 16; ++t) { const float p = __expf(s[t][r] - mx); s[t][r] = p; ps += p; }
#pragma unroll
        for (int off = 1; off < 16; off <<= 1) ps += __shfl_xor(ps, off);
        const float inv = 1.0f / ps;
#pragma unroll
        for (int t = 0; t < 16; ++t) *(LAS unsigned short*)(Pc + (4 * g + r) * 528 + (16 * t + r16) * 2) = (unsigned short)(cvt_pk_bf16(s[t][r] * inv, 0.f) & 0xffffu);
    }
#pragma unroll 1
    for (int dc = 0; dc < 4; ++dc) {
        __syncthreads();
#pragma unroll
        for (int i = 0; i < 8; ++i) { const int idx = tid + 512 * i, d = idx >> 5, c = idx & 31;
            const u32x4 w = *(const u32x4*)(VCt + (size_t)(hd * 512 + 128 * dc + d) * MEMT + b * 256 + 8 * c); *(LAS u32x4*)(RA + d * 528 + c * 16) = w; }
        __syncthreads();
        f32x4 o[8];
#pragma unroll
        for (int d = 0; d < 8; ++d) o[d] = (f32x4){0.f, 0.f, 0.f, 0.f};
#pragma unroll
        for (int ks2 = 0; ks2 < 8; ++ks2) { const bf16x8 pa = *(const LAS bf16x8*)(Pc + r16 * 528 + 64 * ks2 + 16 * g);
#pragma unroll
            for (int d = 0; d < 8; ++d) { const bf16x8 vb = *(const LAS bf16x8*)(RA + (16 * d + r16) * 528 + 64 * ks2 + 16 * g); o[d] = mfma16(pa, vb, o[d]); } }
#pragma unroll
        for (int r = 0; r < 4; ++r) { bf16_t* op = OC + (tokq + 4 * g + r) * D + hd * 512 + 128 * dc + r16;
#pragma unroll
            for (int d = 0; d < 8; ++d) op[16 * d] = f2bf_sw(o[d][r]); }
    }
}

__global__ void __launch_bounds__(512, 2) fwd(Args a) {
    extern __shared__ __attribute__((aligned(16))) unsigned char lds_raw[];
    LAS unsigned char* lds = (LAS unsigned char*)lds_raw;
    cg::grid_group grid = cg::this_grid();
    const int tid = threadIdx.x, lane = tid & 63, wave = __builtin_amdgcn_readfirstlane(tid >> 6);
    const int G = gridDim.x, bx = blockIdx.x;
    const int lo = a.lo, hi = a.hi;
    unsigned char* ws = a.ws;
    const float* x = a.in[0]; const float* mem = a.in[1]; const float* norm_mix_g = a.in[2]; const float* w_in = a.in[3]; const float* b_in = a.in[4];
    const float* conv_w = a.in[5]; const float* conv_b = a.in[6]; const float* conv_ln_g = a.in[7]; const float* conv_ln_b = a.in[8];
    const float* w_conv_out = a.in[9]; const float* w_att_out = a.in[10]; const float* w_out = a.in[11]; const float* norm_cross_g = a.in[12]; const float* norm_mem_g = a.in[13];
    const float* w_cq = a.in[14]; const float* w_ckv = a.in[15]; const float* w_co = a.in[16]; const float* norm_ffn_g = a.in[17]; const float* w_ffn_in = a.in[18]; const float* w_ffn_out = a.in[19];
    const float* norm_final_g = a.in[20];
    float* ssq1 = (float*)(ws + WS_SSQ); float* ssq2 = ssq1; float* ssq3 = ssq1; float* bias_p = (float*)(ws + WS_CTL + 128 * 1024);
    bf16_t* WIN = (bf16_t*)(ws + WS_WIN); bf16_t* WCKV = (bf16_t*)(ws + WS_WCKV); bf16_t* WCONV = (bf16_t*)(ws + WS_WCONV); bf16_t* WATT = (bf16_t*)(ws + WS_WATT);
    bf16_t* WOUT = (bf16_t*)(ws + WS_WOUT); bf16_t* WCQ = (bf16_t*)(ws + WS_WCQ); bf16_t* WCO = (bf16_t*)(ws + WS_WCO); bf16_t* WFI = (bf16_t*)(ws + WS_WFI); bf16_t* WFO = (bf16_t*)(ws + WS_WFO);
    bf16_t* Hb = (bf16_t*)(ws + WS_H); bf16_t* MN = (bf16_t*)(ws + WS_MN); bf16_t* VGLU = (bf16_t*)(ws + WS_VGLU); bf16_t* Qb = (bf16_t*)(ws + WS_Q); bf16_t* Kb = (bf16_t*)(ws + WS_K);
    bf16_t* VT = (bf16_t*)(ws + WS_VT); bf16_t* SG = (bf16_t*)(ws + WS_SG); bf16_t* KC = (bf16_t*)(ws + WS_KC); bf16_t* VCT = (bf16_t*)(ws + WS_VCT);
    bf16_t* YC = (bf16_t*)(ws + WS_YC); bf16_t* YA = (bf16_t*)(ws + WS_YA); float* PART = (float*)(ws + WS_PART); bf16_t* MERGED = (bf16_t*)(ws + WS_MERGED);
    bf16_t* X1B = (bf16_t*)(ws + WS_X1B); bf16_t* QC = (bf16_t*)(ws + WS_QC); bf16_t* OC = (bf16_t*)(ws + WS_OC); bf16_t* X2B = (bf16_t*)(ws + WS_X2B); bf16_t* ACT = (bf16_t*)(ws + WS_ACT);
    float* out = a.out;
    pg8::bf16_t* const nullb = nullptr; (void)nullb;
#define IN(k) (lo <= (k) && (k) < hi)
#define SEAM(k) do { if (IN(k) && IN((k) + 1)) grid.sync(); } while (0)

    if (IN(0)) {
        LAS float* scr = (LAS float*)(lds + wave * 16640);
        const int gw = bx * 8 + wave, NGW = G * 8;
        constexpr int I0 = 32 * 144, I1 = 32 * 64, I2 = 16 * 32, I3 = 16 * 32, I4 = 32 * 32, I5 = 32 * 32, I6 = 32 * 32, I7 = 32 * 176, I8 = 88 * 32;
        constexpr int NIT = I0 + I1 + I2 + I3 + I4 + I5 + I6 + I7 + I8;
        for (int it = gw; it < NIT; it += NGW) {
            int r = it;
            if (r < I0) { tr_item(w_in, D, 9216, WIN, 1, nullptr, scr, r, lane); continue; } r -= I0;
            if (r < I7) { tr_item(w_ffn_in, D, 2 * DFF, WFI, 2, norm_ffn_g, scr, r, lane); continue; } r -= I7;
            if (r < I8) { tr_item(w_ffn_out, DFF, D, WFO, 0, nullptr, scr, r, lane); continue; } r -= I8;
            if (r < I1) { tr_item(w_ckv, D, 4096, WCKV, 0, nullptr, scr, r, lane); continue; } r -= I1;
            if (r < I2) { tr_item(w_conv_out, DC, D, WCONV, 0, nullptr, scr, r, lane); continue; } r -= I2;
            if (r < I3) { tr_item(w_att_out, DA, D, WATT, 0, nullptr, scr, r, lane); continue; } r -= I3;
            if (r < I4) { tr_item(w_out, D, D, WOUT, 0, nullptr, scr, r, lane); continue; } r -= I4;
            if (r < I5) { tr_item(w_cq, D, D, WCQ, 0, norm_cross_g, scr, r, lane); continue; } r -= I5;
            tr_item(w_co, D, D, WCO, 0, nullptr, scr, r, lane);
        }
        for (int m = gw; m < T; m += NGW) rms_row_bf16(x + (size_t)m * D, norm_mix_g, Hb + (size_t)m * D, lane);
        for (int m = gw; m < MEMT; m += NGW) rms_row_bf16(mem + (size_t)m * D, norm_mem_g, MN + (size_t)m * D, lane);
        for (int i = bx * 512 + tid; i < 9216; i += G * 512) bias_p[map_win(i)] = b_in[i];
    }
    SEAM(0);
    if (IN(1)) {
        { pg8::Gemm gm{Hb, WIN, T, 8192, D}; pg8::StaticOrder S; S.init(T, 8192, G, bx);
          pg8::EpiProj E{VGLU, Qb, (WS_K - WS_Q) / 2, (WS_SG - WS_Q) / 2, bias_p};
          pg8::gemm_phase<pg8::EpiProj, pg8::StaticOrder, true, true>(lds, gm, S, E); }
#pragma unroll 1
        for (int gi = 0; gi < 3; ++gi) {
            const size_t offA = gi == 0 ? WS_WIN + (size_t)8192 * D * 2 : (gi == 1 ? WS_MN : WS_WCKV + (size_t)2048 * D * 2);
            const size_t offB = gi == 0 ? WS_H : (gi == 1 ? WS_WCKV : WS_MN);
            const size_t offO = gi == 0 ? WS_VT : (gi == 1 ? WS_KC : WS_VCT);
            const int gM = gi == 0 ? 1024 : (gi == 1 ? MEMT : 2048), gN = gi == 0 ? T : (gi == 1 ? 2048 : MEMT), shift = gi == 0 ? 0 : (gi == 1 ? 128 : 160);
            pg8::Gemm gm{(const bf16_t*)(ws + offA), (const bf16_t*)(ws + offB), gM, gN, D};
            pg8::EpiPlain E{(bf16_t*)(ws + offO), gN, bias_p + 8192, gi == 0 ? 1 : 0};
            pg8::StaticOrder S; S.init(gM, gN, G, (bx + G - (shift % G)) % G);
            pg8::gemm_phase<pg8::EpiPlain, pg8::StaticOrder, true, true>(lds, gm, S, E);
        }
    }
    SEAM(1);
    if (IN(2)) {
        for (int t = bx; t < T / 16; t += G) conv_unit(lds, t, VGLU, conv_w, conv_b, conv_ln_g, conv_ln_b, YC, tid, wave, lane);
        for (int c = bx; c < 256; c += G) { const int bh = c >> 3, qa = c & 7;
            moba_unit(lds, bh >> 3, bh & 7, 15 - qa, Qb, Kb, VT, YA, tid, wave, lane);
            moba_unit(lds, bh >> 3, bh & 7, qa, Qb, Kb, VT, YA, tid, wave, lane); }
        __syncthreads();
    }
    SEAM(2);
    if (IN(3)) {
        { pg8::Gemm gm{YC, WCONV, T, D, DC}; pg8::StaticOrder S; S.init(T, D, G, bx); pg8::EpiGate<false> E{SG, PART, MERGED};
          pg8::gemm_phase<pg8::EpiGate<false>, pg8::StaticOrder, true, true>(lds, gm, S, E); }
        { pg8::Gemm gm{YA, WATT, T, D, DA}; pg8::StaticOrder S; S.init(T, D, G, bx); pg8::EpiGate<true> E{SG + 2048, PART, MERGED};
          pg8::gemm_phase<pg8::EpiGate<true>, pg8::StaticOrder, true, true>(lds, gm, S, E); }
    }
    SEAM(3);
    if (IN(4)) {
        pg8::Gemm gm{MERGED, WOUT, T, D, D}; pg8::StaticOrder S; S.init(T, D, G, bx); pg8::EpiResid<true> E{x, out, X1B, ssq1};
        pg8::gemm_phase<pg8::EpiResid<true>, pg8::StaticOrder, true, true>(lds, gm, S, E);
    }
    SEAM(4);
    if (IN(5)) {
#ifdef DBG_ZERO_OC
        for (size_t i = (size_t)bx * 512 + tid; i < (size_t)T * D / 8; i += (size_t)G * 512) ((u32x4*)OC)[i] = (u32x4){0u, 0u, 0u, 0u};
#endif
        pg8::Gemm gm{X1B, WCQ, T, D, D}; pg8::StaticOrder S; S.init(T, D, G, bx); pg8::EpiRowScale E{QC, ssq1, 0.04419417382415922f};
        pg8::gemm_phase<pg8::EpiRowScale, pg8::StaticOrder, true, true>(lds, gm, S, E);
    }
    SEAM(5);
    if (IN(6)) {
        for (int c = bx; c < 256; c += G) cross_unit(lds, c >> 6, (c >> 4) & 3, c & 15, QC, KC, VCT, OC, tid, wave, lane);
        __syncthreads();
    }
    SEAM(6);
    if (IN(7)) {
        pg8::Gemm gm{OC, WCO, T, D, D}; pg8::StaticOrder S; S.init(T, D, G, bx); pg8::EpiResid<true> E{out, out, X2B, ssq2};
        pg8::gemm_phase<pg8::EpiResid<true>, pg8::StaticOrder, true, true>(lds, gm, S, E);
    }
    SEAM(7);
    if (IN(8)) {
        pg8::Gemm gm{X2B, WFI, T, 2 * DFF, D}; pg8::StaticOrder S; S.init(T, 2 * DFF, G, bx); pg8::EpiSwiglu E{ACT, ssq2};
        pg8::gemm_phase<pg8::EpiSwiglu, pg8::StaticOrder, true, true>(lds, gm, S, E);
    }
    SEAM(8);
    if (IN(9)) {
        pg8::Gemm gm{ACT, WFO, T, D, DFF}; pg8::StaticOrder S; S.init(T, D, G, bx); pg8::EpiResid<false> E{out, out, nullptr, ssq3};
        pg8::gemm_phase<pg8::EpiResid<false>, pg8::StaticOrder, true, true>(lds, gm, S, E);
    }
    SEAM(9);
    if (IN(10)) {
        const int gw = bx * 8 + wave, NGW = G * 8;
        for (int m = gw; m < T; m += NGW) { const float rs = rsqrtf(wave_sum(lane < 32 ? ssq3[(size_t)m * 32 + lane] : 0.f) * (1.0f / 2048.0f) + EPS); f32x4* xr = (f32x4*)(out + (size_t)m * D) + lane;
#pragma unroll
            for (int j = 0; j < 8; ++j) { const f32x4 gg = ((const f32x4*)norm_final_g)[64 * j + lane]; xr[64 * j] = xr[64 * j] * rs * gg; } }
    }
#undef IN
#undef SEAM
}


#ifdef DBG_STOP
__device__ __forceinline__ float dsan(unsigned short b) { float v = __uint_as_float(((unsigned)b) << 16); return (v == v && fabsf(v) < 1e30f) ? v : 1000.0f; }
__global__ void dbg_copy(unsigned char* ws, float* out) {
    const bf16_t* Qb = (const bf16_t*)(ws + WS_Q); const bf16_t* Kb = (const bf16_t*)(ws + WS_K); const bf16_t* VT = (const bf16_t*)(ws + WS_VT); const bf16_t* VG = (const bf16_t*)(ws + WS_VGLU);
    const bf16_t* SG = (const bf16_t*)(ws + WS_SG); const bf16_t* KC = (const bf16_t*)(ws + WS_KC); const bf16_t* VCT = (const bf16_t*)(ws + WS_VCT);
    const bf16_t* YC = (const bf16_t*)(ws + WS_YC); const bf16_t* YA = (const bf16_t*)(ws + WS_YA); const bf16_t* MG = (const bf16_t*)(ws + WS_MERGED);
    const bf16_t* QC = (const bf16_t*)(ws + WS_QC); const bf16_t* OC = (const bf16_t*)(ws + WS_OC); const bf16_t* ACT = (const bf16_t*)(ws + WS_ACT);
    const size_t M8 = (size_t)8 << 20, M2 = (size_t)2 << 20, M16 = (size_t)16 << 20;
    for (size_t i = (size_t)blockIdx.x * blockDim.x + threadIdx.x; i < M16; i += (size_t)gridDim.x * blockDim.x) {
        float v = 0.f;
        if (DBG_SET == 1) v = dsan(Qb[i % M8]) + dsan(Kb[i % M8]) + dsan(VT[i % M8]) + dsan(VG[i % M8]) + dsan(SG[i]) + dsan(SG[i + M16]) + dsan(KC[i % M2]) + dsan(VCT[i % M2]);
        if (DBG_SET == 2) v = dsan(YC[i % M8]) + dsan(YA[i % M8]);
        if (DBG_SET == 3) v = dsan(MG[i]);
        if (DBG_SET == 4) { const float o = out[i]; v = (o == o && fabsf(o) < 1e30f) ? o : 1000.0f; }
        if (DBG_SET == 5) v = dsan(QC[i]);
        if (DBG_SET == 6) v = dsan(OC[i]);
        if (DBG_SET == 8) v = dsan(ACT[i]) + dsan(ACT[i + M16]);
        if (DBG_SET == 60) { const float t = __uint_as_float(((unsigned)OC[i]) << 16); v = (t == t && fabsf(t) < 100.f) ? 0.f : 1000.f; }
        if (DBG_SET == 30) v = dsan(KC[i % M2]);
        if (DBG_SET == 31) v = dsan(VCT[i % M2]);
        if (DBG_SET == 20) v = dsan(YC[i % M8]);
        if (DBG_SET == 21) v = dsan(YA[i % M8]);
        out[i] = v;
    }
}
#endif
extern "C" void kernel_launch(void* const* d_in, const int* in_sizes, int n_in, void* d_out, int out_size, void* d_ws, size_t ws_size, hipStream_t stream) {
    static int grid = 0;
    if (grid == 0) {
        int dev = 0, cus = 0, per_cu = 0;
        if (n_in != 21 || ws_size < WS_END) { fprintf(stderr, "kernel_launch: n_in %d ws_size %zu (need %zu)\n", n_in, ws_size, (size_t)WS_END); grid = -1; return; }
        (void)hipGetDevice(&dev); (void)hipDeviceGetAttribute(&cus, hipDeviceAttributeMultiprocessorCount, dev);
        if (hipFuncSetAttribute((const void*)fwd, hipFuncAttributeMaxDynamicSharedMemorySize, LDS_BYTES) != hipSuccess) { fprintf(stderr, "kernel_launch: hipFuncSetAttribute failed\n"); grid = -1; return; }
        if (hipOccupancyMaxActiveBlocksPerMultiprocessor(&per_cu, (const void*)fwd, 512, LDS_BYTES) != hipSuccess || per_cu < 1) { fprintf(stderr, "kernel_launch: occupancy query gave %d\n", per_cu); per_cu = 1; }
        (void)hipGetLastError();
        grid = cus * per_cu;
        fprintf(stderr, "kernel_launch: grid %d (%d CUs x %d), ws %zu\n", grid, cus, per_cu, ws_size);
    }
    if (grid < 0) return;
    Args a{};
    for (int i = 0; i < 21; ++i) a.in[i] = (const float*)d_in[i];
    a.out = (float*)d_out; a.ws = (unsigned char*)d_ws;
#if MK_SPLIT
#ifdef DBG_STOP
    for (int ph = 0; ph < DBG_STOP; ++ph) { a.lo = ph; a.hi = ph + 1; hipLaunchKernelGGL(fwd, dim3(grid), dim3(512), LDS_BYTES, stream, a); }
    hipLaunchKernelGGL(dbg_copy, dim3(2048), dim3(256), 0, stream, (unsigned char*)d_ws, (float*)d_out);
#else
    for (int ph = 0; ph < NPHASE; ++ph) { a.lo = ph; a.hi = ph + 1; hipLaunchKernelGGL(fwd, dim3(grid), dim3(512), LDS_BYTES, stream, a); }
#endif
#else
    a.lo = 0; a.hi = NPHASE;
    void* args[] = {&a};
    hipError_t e = hipLaunchCooperativeKernel((const void*)fwd, dim3(grid), dim3(512), args, LDS_BYTES, stream);
    if (e != hipSuccess) fprintf(stderr, "cooperative launch failed: %s (grid %d)\n", hipGetErrorString(e), grid);
#endif
}
```

```cpp
#include <hip/hip_runtime.h>
#include <hip/hip_cooperative_groups.h>
#include <cstdio>
#include <cstdint>
namespace cg = cooperative_groups;
namespace pg8 {
#define PG8_LAS __attribute__((address_space(3)))
typedef unsigned short bf16_t;
typedef short bf16x8 __attribute__((ext_vector_type(8)));
typedef float f32x4 __attribute__((ext_vector_type(4)));
typedef unsigned u32x4 __attribute__((ext_vector_type(4)));
constexpr int BM = 256, BK = 64, HALF = 128, HTB = HALF * BK * 2  , STAGE_BYTES = 8 * HTB, NXCD = 8, WGM = 8;

__host__ __device__ __forceinline__ int lds_byte(int r, int c) { const int st = (r >> 4) * 2 + (c >> 5), rr = r & 15, cc = c & 31, ob = rr * 64 + cc * 2; return st * 1024 + (ob ^ (((ob >> 9) & 1) << 5)); }
__host__ __device__ __forceinline__ void stage_rc(int b, int& R, int& C) { const int st = b / 1024, sb = b % 1024, swz = sb ^ (((sb >> 9) & 1) << 5); R = (st >> 1) * 16 + swz / 64; C = (st & 1) * 32 + (swz % 64) / 2; }
__host__ __device__ __forceinline__ int perm32(int rho) { const int n = rho >> 4, i = rho & 15; return 8 * (i >> 2) + 4 * n + (i & 3); }

struct Unit { int pm, pn; int koff = 0; };
struct Gemm { const bf16_t* A; const bf16_t* Bt; int M, N, K; int klen = 0; };

struct StaticOrder {
    int nM, nN, nwg, G, c;
    __host__ __device__ void init(int M, int N, int G_, int c_) { nM = M / BM; nN = N / BM; nwg = nM * nN; G = G_; c = c_; }
    __host__ __device__ bool next(int i, Unit& u) const {
        const long L = (long)i * G + c; if (L >= nwg) return false;
        int wgid = (int)L; { const int q = nwg / NXCD, r = nwg % NXCD, xcd = wgid % NXCD, off = wgid / NXCD; wgid = (xcd < r ? xcd * (q + 1) : r * (q + 1) + (xcd - r) * q) + off; }
        const int nig = WGM * nN, gid = wgid / nig, fm = gid * WGM, gsz = (nM - fm) < WGM ? (nM - fm) : WGM;
        u.pm = fm + ((wgid % nig) % gsz); u.pn = (wgid % nig) / gsz; return true;
    }
    __device__ __forceinline__ void a_ready(const Unit&) const {}
    __device__ __forceinline__ void done(const Unit&) const {}
};

typedef __bf16 bf16x2_t __attribute__((ext_vector_type(2)));
typedef float f32x2 __attribute__((ext_vector_type(2)));
__device__ __forceinline__ unsigned cvt_pk_bf16(float lo, float hi) { const f32x2 v = {lo, hi}; const bf16x2_t r = __builtin_convertvector(v, bf16x2_t); return __builtin_bit_cast(unsigned, r); }
__device__ __forceinline__ float sigm(float x) { return __builtin_amdgcn_rcpf(1.0f + __expf(-x)); }
__device__ __forceinline__ float bflo(unsigned w) { return __uint_as_float(w << 16); }
__device__ __forceinline__ float bfhi(unsigned w) { return __uint_as_float(w & 0xffff0000u); }
__device__ __forceinline__ u32x4 pack8(const f32x4 v0, const f32x4 v1) { u32x4 w; w.x = cvt_pk_bf16(v0[0], v0[1]); w.y = cvt_pk_bf16(v0[2], v0[3]); w.z = cvt_pk_bf16(v1[0], v1[1]); w.w = cvt_pk_bf16(v1[2], v1[3]); return w; }
constexpr float RMS_EPS = 1e-6f;

struct EpiProj {
    static constexpr bool PERM = true, AFTER_DRAIN = false, INIT = false, MID = false;
    bf16_t *Vglu, *Q; size_t offK, offSG; const float* bias; float* ksum; const float* rstd0;
    __device__ __forceinline__ void operator()(const f32x4 (&acc)[2][2][4][2], const Unit& u, int wr, int wc, int fr, int fq) const {
        const int row0 = u.pm * BM + wr * 64 + fr, lc = wc * 32 + 8 * fq, bcol0 = u.pn * BM + lc;
        f32x4 bv[2][2];
#pragma unroll
        for (int bj = 0; bj < 2; ++bj)
#pragma unroll
            for (int n = 0; n < 2; ++n) bv[bj][n] = *(const f32x4*)(bias + bcol0 + bj * HALF + 4 * n);
        if (u.pn < 8) {
#pragma unroll
            for (int ai = 0; ai < 2; ++ai)
#pragma unroll
                for (int m = 0; m < 4; ++m) { bf16_t* rowp = Vglu + (size_t)(row0 + ai * HALF + m * 16) * 1024 + u.pn * 128 + lc;
                    const float r = rstd0[row0 + ai * HALF + m * 16]; f32x4 a0 = acc[ai][0][m][0] * r + bv[0][0], a1 = acc[ai][0][m][1] * r + bv[0][1], g0 = acc[ai][1][m][0] * r + bv[1][0], g1 = acc[ai][1][m][1] * r + bv[1][1];
#pragma unroll
                    for (int j = 0; j < 4; ++j) { a0[j] *= sigm(g0[j]); a1[j] *= sigm(g1[j]); }
                    *(u32x4*)rowp = pack8(a0, a1); }
        } else if (u.pn >= 16) {
            bf16_t* base = Q + offSG + (u.pn - 16) * 128 + lc;
#pragma unroll
            for (int ai = 0; ai < 2; ++ai)
#pragma unroll
                for (int m = 0; m < 4; ++m) { const int rr = row0 + ai * HALF + m * 16; const float r = rstd0[rr];
                    f32x4 R[2], SA[2];
#pragma unroll
                    for (int n = 0; n < 2; ++n) { const f32x4 gc = acc[ai][0][m][n] * r + bv[0][n], ga = acc[ai][1][m][n] * r + bv[1][n];
#pragma unroll
                        for (int j = 0; j < 4; ++j) { const float da = 1.0f + fminf(__expf(-ga[j]), 1e30f), dc = 1.0f + __expf(-gc[j]);
                            SA[n][j] = __builtin_amdgcn_rcpf(da); R[n][j] = da * __builtin_amdgcn_rcpf(dc); } }
                    *(u32x4*)(base + (size_t)rr * 4096) = pack8(R[0], R[1]); *(u32x4*)(base + (size_t)rr * 4096 + 2048) = pack8(SA[0], SA[1]); }
        } else {
            const bool sg = false, isk = u.pn >= 12 && u.pn < 16; const int colt = sg ? (u.pn - 16) * 256 : ((u.pn - 8) & 3) * 256, ldc = sg ? 4096 : 1024;
            bf16_t* base = Q + (sg ? offSG : (u.pn >= 12 ? offK : (size_t)0));
#pragma unroll
            for (int ai = 0; ai < 2; ++ai)
#pragma unroll
                for (int m = 0; m < 4; ++m) { const int rr = row0 + ai * HALF + m * 16; const float r = rstd0[rr]; bf16_t* rowp = base + (size_t)rr * ldc + colt + lc;
                    if (isk) rowp = base + ((size_t)((rr >> 11) * 8 + (u.pn - 12) * 2) * 2048 + (rr & 2047)) * 128 + lc;
#pragma unroll
                    for (int bj = 0; bj < 2; ++bj) { f32x4 v0 = acc[ai][bj][m][0] * r + bv[bj][0], v1 = acc[ai][bj][m][1] * r + bv[bj][1];
                        if (sg) {
#pragma unroll
                            for (int j = 0; j < 4; ++j) { v0[j] = sigm(v0[j]); v1[j] = sigm(v1[j]); } }
                        *(u32x4*)(rowp + (isk ? bj * (2048 * 128) : bj * HALF)) = pack8(v0, v1); } }
            if (isk) {
                float* kp = ksum + (size_t)(wr * 32 + u.pm) * 1024 + (u.pn - 12) * 256 + lc;
#pragma unroll
                for (int bj = 0; bj < 2; ++bj)
#pragma unroll
                    for (int n = 0; n < 2; ++n) { f32x4 t = bv[bj][n] * 8.0f;
#pragma unroll
                        for (int ai = 0; ai < 2; ++ai)
#pragma unroll
                            for (int m = 0; m < 4; ++m) t += acc[ai][bj][m][n] * rstd0[row0 + ai * HALF + m * 16];
#pragma unroll
                        for (int j = 0; j < 4; ++j) { float x = t[j]; x += __shfl_xor(x, 1); x += __shfl_xor(x, 2); x += __shfl_xor(x, 4); x += __shfl_xor(x, 8); t[j] = x; }
                        if (fr == 0) *(f32x4*)(kp + bj * HALF + 4 * n) = t; }
            }
        }
    }
};
struct EpiPlain {
    static constexpr bool PERM = true, AFTER_DRAIN = false, INIT = false, MID = false;
    bf16_t* O; int ldc; const float* rowbias; int has_bias; const float* colscale;
    __device__ __forceinline__ void operator()(const f32x4 (&acc)[2][2][4][2], const Unit& u, int wr, int wc, int fr, int fq) const {
        const int row0 = u.pm * BM + wr * 64 + fr, col0 = u.pn * BM + wc * 32 + 8 * fq;
#pragma unroll
        for (int ai = 0; ai < 2; ++ai)
#pragma unroll
            for (int m = 0; m < 4; ++m) { const int row = row0 + ai * HALF + m * 16; const float rb = has_bias ? rowbias[row] : 0.f; bf16_t* rowp = O + (size_t)row * ldc + col0;
#pragma unroll
                for (int bj = 0; bj < 2; ++bj) { f32x4 v0 = acc[ai][bj][m][0], v1 = acc[ai][bj][m][1]; bf16_t* dst = rowp + bj * HALF;
                    if (has_bias) { const float* cs = colscale + col0 + bj * HALF; v0 = v0 * *(const f32x4*)cs + rb; v1 = v1 * *(const f32x4*)(cs + 4) + rb; }
                    if (has_bias) { const int col = col0 + bj * HALF, tp = col & 2047; dst = O + ((((size_t)((col >> 11) * 8 + (row >> 7)) * 32 + (tp >> 6)) * 128 + (row & 127)) * 64 + (tp & 63)); }
                    *(u32x4*)dst = pack8(v0, v1); } }
    }
};
struct HalfOrder : StaticOrder {
    __host__ __device__ bool next(int i, Unit& u) const { if (!StaticOrder::next(i >> 1, u)) return false; u.koff = (i & 1) * 1024; return true; }
};
struct EpiGateFused {
    static constexpr bool PERM = true, AFTER_DRAIN = false, INIT = true, MID = false;
    const bf16_t* SG; bf16_t* MERGED;
    __device__ __forceinline__ void mid(f32x4 (&acc)[2][2][4][2], const Unit& u, int wr, int wc, int fr, int fq) const {
        const int row0 = u.pm * BM + wr * 64 + fr, col0 = u.pn * BM + wc * 32 + 8 * fq;
#pragma unroll
        for (int ai = 0; ai < 2; ++ai)
#pragma unroll
            for (int m = 0; m < 4; ++m) { const bf16_t* sp = SG + (size_t)(row0 + ai * HALF + m * 16) * 4096 + col0;
#pragma unroll
                for (int bj = 0; bj < 2; ++bj) { const u32x4 gr = __builtin_nontemporal_load((const u32x4*)(sp + bj * HALF));
                    f32x4& v0 = acc[ai][bj][m][0]; f32x4& v1 = acc[ai][bj][m][1];
                    v0[0] *= bflo(gr.x); v0[1] *= bfhi(gr.x); v0[2] *= bflo(gr.y); v0[3] *= bfhi(gr.y); v1[0] *= bflo(gr.z); v1[1] *= bfhi(gr.z); v1[2] *= bflo(gr.w); v1[3] *= bfhi(gr.w); }
            }
    }
    __device__ __forceinline__ void init(f32x4 (&acc)[2][2][4][2], const Unit& u, int, int, int, int) const {
        if (u.koff == 0) {
#pragma unroll
            for (int a = 0; a < 2; ++a)
#pragma unroll
                for (int b = 0; b < 2; ++b)
#pragma unroll
                    for (int m = 0; m < 4; ++m) { acc[a][b][m][0] = (f32x4){0.f, 0.f, 0.f, 0.f}; acc[a][b][m][1] = (f32x4){0.f, 0.f, 0.f, 0.f}; } }
    }
    __device__ __forceinline__ void operator()(f32x4 (&acc)[2][2][4][2], const Unit& u, int wr, int wc, int fr, int fq) const {
        if (u.koff == 0) { mid(acc, u, wr, wc, fr, fq); return; }
        const int row0 = u.pm * BM + wr * 64 + fr, col0 = u.pn * BM + wc * 32 + 8 * fq;
#pragma unroll
        for (int ai = 0; ai < 2; ++ai)
#pragma unroll
            for (int m = 0; m < 4; ++m) { const size_t row = (size_t)(row0 + ai * HALF + m * 16);
#pragma unroll
                for (int bj = 0; bj < 2; ++bj) { const int col = col0 + bj * HALF; const u32x4 ga = __builtin_nontemporal_load((const u32x4*)(SG + row * 4096 + 2048 + col));
                    f32x4 v0 = acc[ai][bj][m][0], v1 = acc[ai][bj][m][1];
                    v0[0] *= bflo(ga.x); v0[1] *= bfhi(ga.x); v0[2] *= bflo(ga.y); v0[3] *= bfhi(ga.y); v1[0] *= bflo(ga.z); v1[1] *= bfhi(ga.z); v1[2] *= bflo(ga.w); v1[3] *= bfhi(ga.w);
                    *(u32x4*)(MERGED + row * 2048 + col) = pack8(v0, v1); } }
    }
};
template <bool RB, bool WF, bool WB> struct EpiResid {
    static constexpr bool PERM = true, AFTER_DRAIN = false, INIT = true, MID = false;
    const float* resid; const bf16_t* residb; float* out; bf16_t* xb; float* ssq;
    __device__ __forceinline__ void init(f32x4 (&acc)[2][2][4][2], const Unit& u, int wr, int wc, int fr, int fq) const {
        const int row0 = u.pm * BM + wr * 64 + fr, col0 = u.pn * BM + wc * 32 + 8 * fq;
#pragma unroll
        for (int ai = 0; ai < 2; ++ai)
#pragma unroll
            for (int m = 0; m < 4; ++m)
#pragma unroll
                for (int bj = 0; bj < 2; ++bj) { const size_t off = (size_t)(row0 + ai * HALF + m * 16) * 2048 + col0 + bj * HALF;
                    if (RB) { const u32x4 w = __builtin_nontemporal_load((const u32x4*)(residb + off));
                        acc[ai][bj][m][0] = (f32x4){bflo(w.x), bfhi(w.x), bflo(w.y), bfhi(w.y)}; acc[ai][bj][m][1] = (f32x4){bflo(w.z), bfhi(w.z), bflo(w.w), bfhi(w.w)}; }
                    else { acc[ai][bj][m][0] = __builtin_nontemporal_load((const f32x4*)(resid + off)); acc[ai][bj][m][1] = __builtin_nontemporal_load((const f32x4*)(resid + off + 4)); } }
    }
    __device__ __forceinline__ void operator()(const f32x4 (&acc)[2][2][4][2], const Unit& u, int wr, int wc, int fr, int fq) const {
        const int row0 = u.pm * BM + wr * 64 + fr, col0 = u.pn * BM + wc * 32 + 8 * fq;
#pragma unroll
        for (int ai = 0; ai < 2; ++ai)
#pragma unroll
            for (int m = 0; m < 4; ++m) { const size_t row = (size_t)(row0 + ai * HALF + m * 16); float sq = 0.f;
#pragma unroll
                for (int bj = 0; bj < 2; ++bj) { const size_t off = row * 2048 + col0 + bj * HALF;
                    const f32x4 v0 = acc[ai][bj][m][0], v1 = acc[ai][bj][m][1];
                    if (WF) { *(f32x4*)(out + off) = v0; *(f32x4*)(out + off + 4) = v1; }
                    sq += (v0[0] * v0[0] + v0[1] * v0[1]) + (v0[2] * v0[2] + v0[3] * v0[3]) + (v1[0] * v1[0] + v1[1] * v1[1]) + (v1[2] * v1[2] + v1[3] * v1[3]);
                    if (WB) *(u32x4*)(xb + off) = pack8(v0, v1); }
                sq += __shfl_xor(sq, 16); sq += __shfl_xor(sq, 32);
                if (fq == 0) ssq[row * 32 + u.pn * 4 + wc] = sq; }
    }
};

struct EpiFinal {
    static constexpr bool PERM = true, AFTER_DRAIN = false, INIT = true, MID = false;
    const bf16_t* residb; float* out; float* ssq; unsigned* cnt; const float* gfin;
    __device__ __forceinline__ void init(f32x4 (&acc)[2][2][4][2], const Unit& u, int wr, int wc, int fr, int fq) const {
        const int row0 = u.pm * BM + wr * 64 + fr, col0 = u.pn * BM + wc * 32 + 8 * fq;
#pragma unroll
        for (int ai = 0; ai < 2; ++ai)
#pragma unroll
            for (int m = 0; m < 4; ++m)
#pragma unroll
                for (int bj = 0; bj < 2; ++bj) { const size_t off = (size_t)(row0 + ai * HALF + m * 16) * 2048 + col0 + bj * HALF; const u32x4 w = __builtin_nontemporal_load((const u32x4*)(residb + off));
                    acc[ai][bj][m][0] = (f32x4){bflo(w.x), bfhi(w.x), bflo(w.y), bfhi(w.y)}; acc[ai][bj][m][1] = (f32x4){bflo(w.z), bfhi(w.z), bflo(w.w), bfhi(w.w)}; }
    }
    __device__ __forceinline__ void operator()(const f32x4 (&acc)[2][2][4][2], const Unit& u, int wr, int wc, int fr, int fq) const {
        const int row0 = u.pm * BM + wr * 64 + fr, col0 = u.pn * BM + wc * 32 + 8 * fq;
#pragma unroll
        for (int ai = 0; ai < 2; ++ai)
#pragma unroll
            for (int m = 0; m < 4; ++m) { const size_t row = (size_t)(row0 + ai * HALF + m * 16); float sq = 0.f;
#pragma unroll
                for (int bj = 0; bj < 2; ++bj) { const f32x4 v0 = acc[ai][bj][m][0], v1 = acc[ai][bj][m][1];
                    sq += (v0[0] * v0[0] + v0[1] * v0[1]) + (v0[2] * v0[2] + v0[3] * v0[3]) + (v1[0] * v1[0] + v1[1] * v1[1]) + (v1[2] * v1[2] + v1[3] * v1[3]); }
                sq += __shfl_xor(sq, 16); sq += __shfl_xor(sq, 32);
                if (fq == 0) __hip_atomic_store(ssq + row * 32 + u.pn * 4 + wc, sq, __ATOMIC_RELAXED, __HIP_MEMORY_SCOPE_AGENT); }
        asm volatile("s_waitcnt vmcnt(0)" ::: "memory");
        unsigned* c = cnt + 64 * u.pm;
        if (fr == 0 && fq == 0) __hip_atomic_fetch_add(c, 1u, __ATOMIC_RELAXED, __HIP_MEMORY_SCOPE_AGENT);
        { unsigned sp = 0u; while ((unsigned)__builtin_amdgcn_readfirstlane(__hip_atomic_load(c, __ATOMIC_RELAXED, __HIP_MEMORY_SCOPE_AGENT)) < 64u) { __builtin_amdgcn_s_sleep(2); if (++sp > (1u << 20)) break; } }
        __builtin_amdgcn_fence(__ATOMIC_ACQUIRE, "agent");
#pragma unroll
        for (int ai = 0; ai < 2; ++ai)
#pragma unroll
            for (int m = 0; m < 4; ++m) { const size_t row = (size_t)(row0 + ai * HALF + m * 16); const float* sp = ssq + row * 32 + fq * 8; float t = 0.f;
#pragma unroll
                for (int i = 0; i < 8; ++i) t += __hip_atomic_load(sp + i, __ATOMIC_RELAXED, __HIP_MEMORY_SCOPE_AGENT);
                t += __shfl_xor(t, 16); t += __shfl_xor(t, 32);
                const float rs = rsqrtf(t * (1.0f / 2048.0f) + RMS_EPS);
#pragma unroll
                for (int bj = 0; bj < 2; ++bj) { const int col = col0 + bj * HALF; const size_t off = row * 2048 + col;
                    const f32x4 g0 = *(const f32x4*)(gfin + col), g1 = *(const f32x4*)(gfin + col + 4);
                    __builtin_nontemporal_store(acc[ai][bj][m][0] * rs * g0, (f32x4*)(out + off)); __builtin_nontemporal_store(acc[ai][bj][m][1] * rs * g1, (f32x4*)(out + off + 4)); } }
    }
};
__device__ __forceinline__ float row_ssq(const float* ssq, size_t row, int fq) {
    const float* sp = ssq + row * 32 + fq * 8; const f32x4 a = *(const f32x4*)sp, b = *(const f32x4*)(sp + 4);
    float s = ((a[0] + a[1]) + (a[2] + a[3])) + ((b[0] + b[1]) + (b[2] + b[3]));
    s += __shfl_xor(s, 16); s += __shfl_xor(s, 32); return s;
}
struct EpiRowScale {
    static constexpr bool PERM = true, AFTER_DRAIN = false, INIT = false, MID = false;
    bf16_t* O; const float* ssq; float mul;
    __device__ __forceinline__ void operator()(const f32x4 (&acc)[2][2][4][2], const Unit& u, int wr, int wc, int fr, int fq) const {
        const int row0 = u.pm * BM + wr * 64 + fr, col0 = u.pn * BM + wc * 32 + 8 * fq;
#pragma unroll
        for (int ai = 0; ai < 2; ++ai)
#pragma unroll
            for (int m = 0; m < 4; ++m) { const size_t row = (size_t)(row0 + ai * HALF + m * 16); const float rs = rsqrtf(row_ssq(ssq, row, fq) * (1.0f / 2048.0f) + RMS_EPS) * mul;
#pragma unroll
                for (int bj = 0; bj < 2; ++bj) *(u32x4*)(O + row * 2048 + col0 + bj * HALF) = pack8(acc[ai][bj][m][0] * rs, acc[ai][bj][m][1] * rs); }
    }
};
struct EpiSwiglu {
    static constexpr bool PERM = true, AFTER_DRAIN = false, INIT = false, MID = false;
    bf16_t* ACT; const float* ssq;
    __device__ __forceinline__ void operator()(const f32x4 (&acc)[2][2][4][2], const Unit& u, int wr, int wc, int fr, int fq) const {
        const int row0 = u.pm * BM + wr * 64 + fr, lc = wc * 32 + 8 * fq;
#pragma unroll
        for (int ai = 0; ai < 2; ++ai)
#pragma unroll
            for (int m = 0; m < 4; ++m) { const size_t row = (size_t)(row0 + ai * HALF + m * 16); const float rs = rsqrtf(row_ssq(ssq, row, fq) * (1.0f / 2048.0f) + RMS_EPS);
                f32x4 g0 = acc[ai][0][m][0] * rs, g1 = acc[ai][0][m][1] * rs, u0 = acc[ai][1][m][0] * rs, u1 = acc[ai][1][m][1] * rs;
#pragma unroll
                for (int j = 0; j < 4; ++j) { g0[j] = g0[j] * sigm(g0[j]) * u0[j]; g1[j] = g1[j] * sigm(g1[j]) * u1[j]; }
                *(u32x4*)(ACT + row * 5632 + u.pn * 128 + lc) = pack8(g0, g1); }
    }
};

template <class Epi, class Sched, bool ALIGN_EPI = false, bool SP2 = false>
__device__ __forceinline__ void gemm_phase(PG8_LAS unsigned char* lds, const Gemm g, const Sched& S, const Epi& E) {
    const int tid = threadIdx.x, wid = __builtin_amdgcn_readfirstlane(tid >> 6), lane = tid & 63, wr = wid >> 2, wc = wid & 3, fr = lane & 15, fq = lane >> 4;
    const int K = g.K, nt = (g.klen ? g.klen : K) / BK;
    unsigned voffA[2], voffB[2];
#pragma unroll
    for (int i = 0; i < 2; ++i) { int R, C; stage_rc(tid * 16 + i * 8192, R, C); const int Rb = Epi::PERM ? ((R & ~31) + perm32(R & 31)) : R;
        voffA[i] = (unsigned)(R * K + C) * 2u; voffB[i] = (unsigned)(Rb * K + C) * 2u; }
    const size_t kstep = (size_t)(BK * 2);
    const size_t hstep = (size_t)HALF * K * 2;
    const size_t tstep = 2 * hstep;
    const unsigned ldsw = (unsigned)wid * 1024u;
    const int aoff = lds_byte(wr * 64 + fr, fq * 8), boff = lds_byte(wc * 32 + fr, fq * 8);
#define PG8_SA(b, h) (((b) * 2 + (h)) * HTB)
#define PG8_SB(b, h) ((4 + (b) * 2 + (h)) * HTB)
#define PG8_STAGE(bufoff, gbase, voff) do { _Pragma("unroll") for (int _i = 0; _i < 2; ++_i) \
        __builtin_amdgcn_global_load_lds((const unsigned*)((const char*)(gbase) + (voff)[_i]), (PG8_LAS unsigned*)(lds + (bufoff) + ldsw + _i * 8192), 16, 0, 0); } while (0)
#define PG8_LDA(dst, b, h) do { _Pragma("unroll") for (int m = 0; m < 4; ++m) _Pragma("unroll") for (int k = 0; k < 2; ++k) dst[m][k] = *(const PG8_LAS bf16x8*)(lds + PG8_SA(b, h) + aoff + m * 2048 + k * 1024); } while (0)
#define PG8_LDB(dst, b, h) do { _Pragma("unroll") for (int n = 0; n < 2; ++n) _Pragma("unroll") for (int k = 0; k < 2; ++k) dst[n][k] = *(const PG8_LAS bf16x8*)(lds + PG8_SB(b, h) + boff + n * 2048 + k * 1024); } while (0)
#define PG8_MMA(ai, bj, At, Bt) do { __builtin_amdgcn_s_setprio(1); _Pragma("unroll") for (int m = 0; m < 4; ++m) _Pragma("unroll") for (int n = 0; n < 2; ++n) _Pragma("unroll") for (int k = 0; k < 2; ++k) \
        acc[ai][bj][m][n] = __builtin_amdgcn_mfma_f32_16x16x32_bf16(Bt[n][k], At[m][k], acc[ai][bj][m][n], 0, 0, 0); __builtin_amdgcn_s_setprio(0); } while (0)
#define PG8_WAIT_V(n) asm volatile("s_waitcnt vmcnt(" #n ")" ::: "memory")
#define PG8_WAIT_L(n) asm volatile("s_waitcnt lgkmcnt(" #n ")" ::: "memory")
#define PG8_BAR __builtin_amdgcn_s_barrier()
#define PG8_SCHED __builtin_amdgcn_sched_barrier(0)
    Unit cur, nxt; int ui = 0;
    if (!S.next(0, cur)) return;
    f32x4 acc[2][2][4][2];
    if constexpr (Epi::INIT) E.init(acc, cur, wr, wc, fr, fq);
    else {
#pragma unroll
    for (int a = 0; a < 2; ++a)
#pragma unroll
        for (int b = 0; b < 2; ++b)
#pragma unroll
            for (int m = 0; m < 4; ++m)
#pragma unroll
                for (int n = 0; n < 2; ++n) acc[a][b][m][n] = (f32x4){0.f, 0.f, 0.f, 0.f};
    }
    bf16x8 At[4][2], B0[2][2], B1[2][2];
    const char* cA = (const char*)g.A + (size_t)cur.pm * tstep + (size_t)cur.koff * 2; const char* cB = (const char*)g.Bt + (size_t)cur.pn * tstep + (size_t)cur.koff * 2;
    S.a_ready(cur);
    if constexpr (SP2) {
        PG8_STAGE(PG8_SB(0, 0), cB, voffB); PG8_STAGE(PG8_SB(0, 1), cB + hstep, voffB); PG8_STAGE(PG8_SA(0, 0), cA, voffA); PG8_STAGE(PG8_SA(0, 1), cA + hstep, voffA);
        if (wr == 1) PG8_BAR;
        PG8_WAIT_V(2); PG8_BAR;
        PG8_STAGE(PG8_SB(1, 0), cB + kstep, voffB); PG8_STAGE(PG8_SA(1, 0), cA + kstep, voffA); PG8_STAGE(PG8_SB(1, 1), cB + hstep + kstep, voffB);
        PG8_WAIT_V(6); PG8_BAR;
    } else {
        PG8_STAGE(PG8_SB(0, 0), cB, voffB); PG8_STAGE(PG8_SA(0, 0), cA, voffA); PG8_STAGE(PG8_SB(0, 1), cB + hstep, voffB); PG8_STAGE(PG8_SA(0, 1), cA + hstep, voffA);
        if (wr == 1) PG8_BAR;
        PG8_WAIT_V(4); PG8_BAR;
        PG8_STAGE(PG8_SB(1, 0), cB + kstep, voffB); PG8_STAGE(PG8_SA(1, 0), cA + kstep, voffA); PG8_STAGE(PG8_SB(1, 1), cB + hstep + kstep, voffB);
        PG8_WAIT_V(6); PG8_BAR;
    }
    for (;;) {
        const bool has_next = S.next(ui + 1, nxt);
        const char* nA = has_next ? (const char*)g.A + (size_t)nxt.pm * tstep + (size_t)nxt.koff * 2 : cA; const char* nB = has_next ? (const char*)g.Bt + (size_t)nxt.pn * tstep + (size_t)nxt.koff * 2 : cB;
        for (int t = 0; t < nt; t += 2) {
            const bool last = (t == nt - 2);
            const char* a1 = cA + (size_t)(t + 1) * kstep;
            const char* a2 = last ? nA : cA + (size_t)(t + 2) * kstep; const char* b2 = last ? nB : cB + (size_t)(t + 2) * kstep;
            const char* a3 = a2 + kstep; const char* b3 = b2 + kstep;
            if (last && has_next) S.a_ready(nxt);
            if constexpr (SP2) {
            PG8_LDB(B0, 0, 0); PG8_LDB(B1, 0, 1); PG8_SCHED; PG8_LDA(At, 0, 0); PG8_STAGE(PG8_SA(1, 1), a1 + hstep, voffA);
            PG8_WAIT_V(8); PG8_WAIT_L(0); PG8_BAR; PG8_MMA(0, 0, At, B0); PG8_MMA(0, 1, At, B1); PG8_BAR; PG8_SCHED;
            PG8_LDA(At, 0, 1); PG8_STAGE(PG8_SB(0, 0), b2, voffB); PG8_STAGE(PG8_SB(0, 1), b2 + hstep, voffB); PG8_STAGE(PG8_SA(0, 0), a2, voffA);
            PG8_WAIT_V(8); PG8_WAIT_L(0); PG8_BAR; PG8_MMA(1, 0, At, B0); PG8_MMA(1, 1, At, B1); PG8_BAR; PG8_SCHED;
            PG8_LDB(B0, 1, 0); PG8_LDB(B1, 1, 1); PG8_SCHED; PG8_LDA(At, 1, 0); PG8_STAGE(PG8_SA(0, 1), a2 + hstep, voffA);
            PG8_WAIT_V(8); PG8_WAIT_L(0); PG8_BAR; PG8_MMA(0, 0, At, B0); PG8_MMA(0, 1, At, B1); PG8_BAR; PG8_SCHED;
            PG8_LDA(At, 1, 1); PG8_STAGE(PG8_SB(1, 0), b3, voffB); PG8_STAGE(PG8_SB(1, 1), b3 + hstep, voffB); PG8_STAGE(PG8_SA(1, 0), a3, voffA);
            PG8_WAIT_V(8); PG8_WAIT_L(0); PG8_BAR; PG8_MMA(1, 0, At, B0); PG8_MMA(1, 1, At, B1); PG8_BAR; PG8_SCHED;
            } else {
            PG8_LDB(B0, 0, 0); PG8_SCHED; PG8_LDA(At, 0, 0); PG8_STAGE(PG8_SA(1, 1), a1 + hstep, voffA);
            PG8_WAIT_L(8); PG8_BAR; PG8_WAIT_L(0); PG8_MMA(0, 0, At, B0); PG8_BAR; PG8_SCHED;
            PG8_LDB(B1, 0, 1); PG8_STAGE(PG8_SB(0, 0), b2, voffB);
            PG8_BAR; PG8_WAIT_L(0); PG8_MMA(0, 1, At, B1); PG8_BAR;
            PG8_LDA(At, 0, 1); PG8_STAGE(PG8_SA(0, 0), a2, voffA);
            PG8_BAR; PG8_WAIT_L(0); PG8_MMA(1, 0, At, B0); PG8_BAR; PG8_SCHED;
            PG8_STAGE(PG8_SB(0, 1), b2 + hstep, voffB);
            PG8_WAIT_V(6); PG8_BAR; PG8_MMA(1, 1, At, B1); PG8_BAR;
            PG8_LDB(B0, 1, 0); PG8_SCHED; PG8_LDA(At, 1, 0); PG8_STAGE(PG8_SA(0, 1), a2 + hstep, voffA);
            PG8_WAIT_L(8); PG8_BAR; PG8_WAIT_L(0); PG8_MMA(0, 0, At, B0); PG8_BAR; PG8_SCHED;
            PG8_LDB(B1, 1, 1); PG8_STAGE(PG8_SB(1, 0), b3, voffB);
            PG8_BAR; PG8_WAIT_L(0); PG8_MMA(0, 1, At, B1); PG8_BAR;
            PG8_LDA(At, 1, 1); PG8_STAGE(PG8_SA(1, 0), a3, voffA);
            PG8_BAR; PG8_WAIT_L(0); PG8_MMA(1, 0, At, B0); PG8_BAR; PG8_SCHED;
            PG8_STAGE(PG8_SB(1, 1), b3 + hstep, voffB);
            PG8_WAIT_V(6); PG8_BAR; PG8_MMA(1, 1, At, B1); PG8_BAR;
            }
        }
        if constexpr (ALIGN_EPI) { if (wr == 0) PG8_BAR; }
        if constexpr (!Epi::AFTER_DRAIN) { E(acc, cur, wr, wc, fr, fq); S.done(cur); }
        if (!has_next) break;
        if constexpr (Epi::INIT) E.init(acc, nxt, wr, wc, fr, fq);
        else {
#pragma unroll
        for (int a = 0; a < 2; ++a)
#pragma unroll
            for (int b = 0; b < 2; ++b)
#pragma unroll
                for (int m = 0; m < 4; ++m)
#pragma unroll
                    for (int n = 0; n < 2; ++n) acc[a][b][m][n] = (f32x4){0.f, 0.f, 0.f, 0.f};
        }
        cur = nxt; cA = nA; cB = nB; ++ui;
        if constexpr (ALIGN_EPI) { if (wr == 1) PG8_BAR; }
    }
    PG8_WAIT_V(0);
    if constexpr (!ALIGN_EPI) { if (wr == 0) PG8_BAR; }
    PG8_BAR;
    if constexpr (Epi::AFTER_DRAIN) { E.fused(acc, cur, wr, wc, fr, fq, lds, wid, lane); S.done(cur); }
#undef PG8_SA
#undef PG8_SB
#undef PG8_STAGE
#undef PG8_LDA
#undef PG8_LDB
#undef PG8_MMA
#undef PG8_WAIT_V
#undef PG8_WAIT_L
#undef PG8_BAR
#undef PG8_SCHED
}
}

#define LAS __attribute__((address_space(3)))
typedef unsigned short bf16_t;
typedef float f32x4 __attribute__((ext_vector_type(4)));
typedef float f32x2v __attribute__((ext_vector_type(2)));
typedef unsigned u32x4 __attribute__((ext_vector_type(4)));
typedef unsigned u32x2 __attribute__((ext_vector_type(2)));
typedef short bf16x8 __attribute__((ext_vector_type(8)));
using pg8::bflo; using pg8::bfhi; using pg8::cvt_pk_bf16; using pg8::sigm;

#ifndef MK_SPLIT
#define MK_SPLIT 0
#endif
constexpr int NPHASE = 11;
constexpr int T = 8192, D = 2048, SEQ = 2048, NB = 4, DC = 1024, DA = 1024, DFF = 5632, MEMT = 1024;
constexpr float EPS = 1e-6f;
constexpr int LDS_BYTES = 139264;
constexpr size_t MiB = 1u << 20;
constexpr size_t WS_CTL = 0;
constexpr size_t WS_SSQ = 151 * MiB;
constexpr size_t WS_WIN = 1 * MiB;
constexpr size_t WS_WCKV = 37 * MiB;
constexpr size_t WS_WCONV = 53 * MiB;
constexpr size_t WS_WATT = 57 * MiB;
constexpr size_t WS_WOUT = 61 * MiB;
constexpr size_t WS_WCQ = 69 * MiB;
constexpr size_t WS_WCO = 77 * MiB;
constexpr size_t WS_WFI = 85 * MiB;
constexpr size_t WS_WFO = 129 * MiB;
constexpr size_t WS_H = 152 * MiB;
constexpr size_t WS_MN = 184 * MiB;
constexpr size_t WS_VGLU = 188 * MiB;
constexpr size_t WS_Q = 204 * MiB, WS_K = 220 * MiB, WS_VT = 236 * MiB;
constexpr size_t WS_SG = 252 * MiB;
constexpr size_t WS_KC = 316 * MiB, WS_VCT = 320 * MiB;
constexpr size_t WS_YC = 324 * MiB, WS_YA = 340 * MiB;
constexpr size_t WS_PART = 152 * MiB;
constexpr size_t WS_MERGED = 216 * MiB;
constexpr size_t WS_X1B = 1 * MiB;
constexpr size_t WS_QC = 152 * MiB;
constexpr size_t WS_OC = 184 * MiB;
constexpr size_t WS_X2B = 216 * MiB;
constexpr size_t WS_ACT = 252 * MiB;
constexpr size_t WS_END = 356 * MiB;

struct Args { const float* in[21]; float* out; unsigned char* ws; int lo, hi; };

__device__ __forceinline__ float wave_sum(float v) {
#pragma unroll
    for (int o = 1; o < 64; o <<= 1) v += __shfl_xor(v, o);
    return v;
}
#define LDS_WAIT() asm volatile("s_waitcnt lgkmcnt(0)" ::: "memory")

__device__ __forceinline__ int map_win(int n) {
    if (n < 2048) { const int bj = n >> 10, c = n & 1023; return (c >> 7) * 256 + bj * 128 + (c & 127); }
    if (n < 4096) return n;
    if (n < 5120) return 8192 + (n - 4096);
    if (n < 7168) { const int c = n - 5120; return 4096 + (c >> 7) * 256 + (c & 127); }
    { const int c = n - 7168; return 4096 + (c >> 7) * 256 + 128 + (c & 127); }
}
__device__ __forceinline__ int map_ffn(int n) { const int bj = n >= DFF ? 1 : 0, c = n - bj * DFF; return (c >> 7) * 256 + bj * 128 + (c & 127); }
__device__ __forceinline__ void tr_load(const float* W, int N, int item, int lane, f32x4 (&v)[16]) {
    const int nblk = N >> 6, kb = item / nblk, nb = item - kb * nblk;
    const float* src = W + (size_t)(kb * 64 + (lane >> 4)) * N + nb * 64 + 4 * (lane & 15);
#pragma unroll
    for (int i = 0; i < 16; ++i) v[i] = __builtin_nontemporal_load((const f32x4*)(src + (size_t)(4 * i) * N));
}
__device__ __forceinline__ void tr_proc(const f32x4 (&v)[16], int K, int N, bf16_t* WT, int mode, const float* gain, LAS float* scr, int item, int lane, bool nts = false) {
    const int nblk = N >> 6, kb = item / nblk, nb = item - kb * nblk, k0 = kb * 64, n0 = nb * 64;
    const int c16 = lane & 15, r4 = lane >> 4;
#pragma unroll
    for (int i = 0; i < 16; ++i) { LAS float* s = scr + (4 * i + r4) * 65 + 4 * c16; s[0] = v[i][0]; s[1] = v[i][1]; s[2] = v[i][2]; s[3] = v[i][3]; }
    LDS_WAIT();
    const int c = lane & 7;
    float gk[8];
#pragma unroll
    for (int i = 0; i < 8; ++i) gk[i] = gain ? gain[k0 + 8 * c + i] : 1.0f;
#pragma unroll
    for (int j = 0; j < 8; ++j) { const int n = (lane >> 3) + 8 * j; const LAS float* s = scr + (8 * c) * 65 + n;
        u32x4 o; o.x = cvt_pk_bf16(s[0] * gk[0], s[65] * gk[1]); o.y = cvt_pk_bf16(s[130] * gk[2], s[195] * gk[3]); o.z = cvt_pk_bf16(s[260] * gk[4], s[325] * gk[5]); o.w = cvt_pk_bf16(s[390] * gk[6], s[455] * gk[7]);
        const int nn = n0 + n; const int dr = mode == 1 ? map_win(nn) : (mode == 2 ? map_ffn(nn) : nn);
        if (nts) __builtin_nontemporal_store(o, (u32x4*)(WT + (size_t)dr * K + k0 + 8 * c)); else *(u32x4*)(WT + (size_t)dr * K + k0 + 8 * c) = o; }
    LDS_WAIT();
}
__device__ __forceinline__ void xb_row(const float* xrow, bf16_t* orow, float* rstd_out, int lane) {
    const f32x4* xr = (const f32x4*)xrow + lane; f32x4 v[8]; float s = 0.f;
#pragma unroll
    for (int j = 0; j < 8; ++j) { v[j] = __builtin_nontemporal_load(xr + 64 * j); s += (v[j][0] * v[j][0] + v[j][1] * v[j][1]) + (v[j][2] * v[j][2] + v[j][3] * v[j][3]); }
    const float rstd = rsqrtf(wave_sum(s) * (1.0f / 2048.0f) + EPS);
    if (lane == 0) *rstd_out = rstd;
    u32x2* o8 = (u32x2*)orow + lane;
#pragma unroll
    for (int j = 0; j < 8; ++j) { u32x2 w; w.x = cvt_pk_bf16(v[j][0], v[j][1]); w.y = cvt_pk_bf16(v[j][2], v[j][3]); o8[64 * j] = w; }
}
__device__ __forceinline__ void rms_row_bf16(const float* xrow, const float* g, bf16_t* orow, int lane) {
    const f32x4* xr = (const f32x4*)xrow + lane; f32x4 v[8]; float s = 0.f;
#pragma unroll
    for (int j = 0; j < 8; ++j) { v[j] = __builtin_nontemporal_load(xr + 64 * j); s += (v[j][0] * v[j][0] + v[j][1] * v[j][1]) + (v[j][2] * v[j][2] + v[j][3] * v[j][3]); }
    const float rstd = rsqrtf(wave_sum(s) * (1.0f / 2048.0f) + EPS);
    u32x2* o8 = (u32x2*)orow + lane;
#pragma unroll
    for (int j = 0; j < 8; ++j) { const f32x4 gg = ((const f32x4*)g)[64 * j + lane]; u32x2 w; w.x = cvt_pk_bf16(v[j][0] * rstd * gg[0], v[j][1] * rstd * gg[1]); w.y = cvt_pk_bf16(v[j][2] * rstd * gg[2], v[j][3] * rstd * gg[3]); o8[64 * j] = w; }
}

__device__ __forceinline__ void conv_unit(LAS unsigned char* lds, int tile, const bf16_t* Vglu, const float* conv_w, const float* conv_b, const float* ln_g, const float* ln_b, bf16_t* YC, int tid, int wave, int lane) {
    constexpr int TT = 16;
    const int t0 = tile * TT, tb = t0 & (SEQ - 1), c0 = 2 * tid;
    float w0[31], w1[31];
#pragma unroll
    for (int j = 0; j < 31; ++j) { const f32x2v w = *(const f32x2v*)(conv_w + j * DC + c0); w0[j] = w[0]; w1[j] = w[1]; }
    const f32x2v bb = *(const f32x2v*)(conv_b + c0);
    float a0[TT], a1[TT];
#pragma unroll
    for (int t = 0; t < TT; ++t) { a0[t] = bb[0]; a1[t] = bb[1]; }
#pragma unroll
    for (int r = -30; r < TT; ++r) {
        const bool ok = (tb + r) >= 0;
        unsigned w = *(const unsigned*)(Vglu + (size_t)(ok ? t0 + r : t0) * DC + c0);
        w = ok ? w : 0u;
        const float v0 = bflo(w), v1 = bfhi(w);
#pragma unroll
        for (int t = 0; t < TT; ++t) { const int j = r - t + 30; if (j >= 0 && j <= 30) { a0[t] += w0[j] * v0; a1[t] += w1[j] * v1; } }
    }
    LAS float* red = (LAS float*)lds;
    LAS float* stat = (LAS float*)(lds + 65536);
    __syncthreads();
#pragma unroll
    for (int t = 0; t < TT; ++t) { red[(2 * t) * 512 + tid] = a0[t] + a1[t]; red[(2 * t + 1) * 512 + tid] = a0[t] * a0[t] + a1[t] * a1[t]; }
    __syncthreads();
#pragma unroll
    for (int q = 0; q < 4; ++q) { const int st = wave * 4 + q; float s = 0.f;
#pragma unroll
        for (int i = 0; i < 8; ++i) s += red[st * 512 + lane + 64 * i];
        s = wave_sum(s); if (lane == 0) stat[st] = s; }
    __syncthreads();
    const f32x2v lg = *(const f32x2v*)(ln_g + c0), lb = *(const f32x2v*)(ln_b + c0);
#pragma unroll
    for (int t = 0; t < TT; ++t) { const float mean = stat[2 * t] * (1.0f / DC), var = stat[2 * t + 1] * (1.0f / DC) - mean * mean, rstd = rsqrtf(fmaxf(var, 0.f) + EPS);
        const float z0 = (a0[t] - mean) * rstd * lg[0] + lb[0], z1 = (a1[t] - mean) * rstd * lg[1] + lb[1];
        *(unsigned*)(YC + (size_t)(t0 + t) * 2048 + c0) = cvt_pk_bf16(z0 * sigm(z0), z1 * sigm(z1)); }
}

__device__ __forceinline__ bf16_t f2bf_sw(float f) { return (bf16_t)(cvt_pk_bf16(f, 0.f) & 0xffffu); }
__device__ __forceinline__ f32x4 mfma16(bf16x8 a, bf16x8 b, f32x4 c) { return __builtin_amdgcn_mfma_f32_16x16x32_bf16(a, b, c, 0, 0, 0); }
__device__ __forceinline__ void moba_unit(LAS unsigned char* lds, int b, int h, int qt, const bf16_t* Q, const bf16_t* K, const bf16_t* Vt, const float* ksum, bf16_t* YA, int tid, int wave, int lane) {
    const int qb = qt >> 1, half = qt & 1, r16 = lane & 15, g = lane >> 4;
    LAS unsigned char* Ks = lds;
    LAS unsigned char* Vs = lds + 34816;
    LAS float* kmean = (LAS float*)(lds + 69632);
    LAS float* gate = (LAS float*)(lds + 73728);
    LAS unsigned* selm = (LAS unsigned*)(lds + 77824);
    const size_t tok0 = (size_t)b * SEQ;
    const int q0 = qb * 256 + half * 128;
    __syncthreads();
    if (qb > 0) {
        for (int idx = tid; idx < qb * 128; idx += 512) { const int j = idx >> 7, d = idx & 127; const size_t o = (size_t)(b * 8 + j) * 1024 + h * 128 + d;
            kmean[idx] = (ksum[o] + ksum[32 * 1024 + o]) * (1.0f / 256.0f); }
        __syncthreads();
        { const int q = tid & 127, jg = tid >> 7; const bf16_t* qp = Q + (tok0 + q0 + q) * DA + h * 128; float d0 = 0.f, d1 = 0.f;
            const LAS float* km0 = kmean + jg * 128; const LAS float* km1 = kmean + (jg + 4) * 128;
#pragma unroll 4
            for (int c = 0; c < 16; ++c) { const u32x4 w = *(const u32x4*)(qp + 8 * c); const float qv[8] = {bflo(w.x), bfhi(w.x), bflo(w.y), bfhi(w.y), bflo(w.z), bfhi(w.z), bflo(w.w), bfhi(w.w)};
#pragma unroll
                for (int i = 0; i < 8; ++i) { d0 += qv[i] * km0[8 * c + i]; d1 += qv[i] * km1[8 * c + i]; } }
            if (jg < qb) gate[q * 8 + jg] = d0;
            if (jg + 4 < qb) gate[q * 8 + jg + 4] = d1; }
        __syncthreads();
        if (tid < 128) { float gv[8];
#pragma unroll
            for (int j = 0; j < 8; ++j) gv[j] = (j < qb) ? gate[tid * 8 + j] : -__builtin_inff();
            unsigned mask = 0u; const int nsel = qb < 3 ? qb : 3;
#pragma unroll
            for (int s = 0; s < 3; ++s) if (s < nsel) { int best = -1; float bvv = 0.f;
#pragma unroll
                for (int j = 0; j < 8; ++j) { const bool cand = (j < qb) && !((mask >> j) & 1u); if (cand && (best < 0 || gv[j] > bvv)) { best = j; bvv = gv[j]; } }
                mask |= 1u << best; }
            selm[tid] = mask; }
        __syncthreads();
    }
    bf16x8 qf[4];
    { const bf16_t* qp = Q + (tok0 + q0 + wave * 16 + r16) * DA + h * 128 + 8 * g;
#pragma unroll
        for (int ks = 0; ks < 4; ++ks) qf[ks] = __builtin_nontemporal_load((const bf16x8*)(qp + 32 * ks)); }
    const int qrow = wave * 16 + r16, qpos = q0 + qrow;
    const unsigned smq = qb > 0 ? selm[qrow] : 0u;
    f32x4 o[8];
#pragma unroll
    for (int d = 0; d < 8; ++d) o[d] = (f32x4){0.f, 0.f, 0.f, 0.f};
    float mq = -1e30f, lq = 0.f;
    const int n_own = half ? 4 : 2, ntiles = n_own + 4 * qb;
    const float scale = 0.08838834764831845f;
    u32x4 kA[2], vA[2], kB[2], vB[2], kC[2], vC[2], kD[2], vD[2];
#define MOBA_BAR() do { asm volatile("s_waitcnt lgkmcnt(0)" ::: "memory"); __builtin_amdgcn_s_barrier(); asm volatile("" ::: "memory"); } while (0)
#define MOBA_KEY0(i_) (((i_) < n_own) ? (qb * 256 + (i_) * 64) : ((((i_) - n_own) >> 2) * 256 + (((i_) - n_own) & 3) * 64))
#define MOBA_LOAD(i_, kr_, vr_) do { const int k0_ = MOBA_KEY0(i_); _Pragma("unroll") for (int i = 0; i < 2; ++i) { const int idx = tid + 512 * i; \
        kr_[i] = *(const u32x4*)(K + ((size_t)(b * 8 + h) * 2048 + k0_) * 128 + 8 * idx); \
        vr_[i] = *(const u32x4*)(Vt + ((size_t)(b * 8 + h) * 32 + (k0_ >> 6)) * 8192 + 8 * idx); } } while (0)
#define MOBA_PUT(kr_, vr_) do { _Pragma("unroll") for (int i = 0; i < 2; ++i) { const int idx = tid + 512 * i; \
        *(LAS u32x4*)(Ks + (idx >> 4) * 272 + (idx & 15) * 16) = kr_[i]; *(LAS u32x4*)(Vs + (idx >> 3) * 144 + (idx & 7) * 16) = vr_[i]; } } while (0)
#define MOBA_COMPUTE(i_) do { \
        const bool own = (i_) < n_own; const int blk = own ? qb : (((i_) - n_own) >> 2); const int key0 = MOBA_KEY0(i_); \
        f32x4 st[4]; \
        _Pragma("unroll") for (int sub = 0; sub < 4; ++sub) { st[sub] = (f32x4){0.f, 0.f, 0.f, 0.f}; \
            _Pragma("unroll") for (int ks = 0; ks < 4; ++ks) { const bf16x8 kb = *(const LAS bf16x8*)(Ks + (16 * sub + r16) * 272 + 64 * ks + 16 * g); st[sub] = mfma16(kb, qf[ks], st[sub]); } } \
        const bool pastsel = ((smq >> blk) & 1u) != 0u; float mx = -1e30f; \
        _Pragma("unroll") for (int sub = 0; sub < 4; ++sub) \
            _Pragma("unroll") for (int r = 0; r < 4; ++r) { const int kpos = key0 + 16 * sub + 4 * g + r; const bool valid = own ? (kpos <= qpos) : pastsel; \
                const float v = valid ? st[sub][r] * scale : -1e30f; st[sub][r] = v; mx = fmaxf(mx, v); } \
        mx = fmaxf(mx, __shfl_xor(mx, 16)); mx = fmaxf(mx, __shfl_xor(mx, 32)); \
        const float mnew = fmaxf(mq, mx), alpha = __expf(mq - mnew); mq = mnew; float ps = 0.f; \
        _Pragma("unroll") for (int sub = 0; sub < 4; ++sub) \
            _Pragma("unroll") for (int r = 0; r < 4; ++r) { const float pv = (st[sub][r] > -1e29f) ? __expf(st[sub][r] - mnew) : 0.f; st[sub][r] = pv; ps += pv; } \
        lq = lq * alpha + ps; \
        _Pragma("unroll") for (int d = 0; d < 8; ++d) o[d] *= alpha; \
        _Pragma("unroll") for (int ks2 = 0; ks2 < 2; ++ks2) { const bf16x8 pb = __builtin_bit_cast(bf16x8, pg8::pack8(st[2 * ks2], st[2 * ks2 + 1])); \
            _Pragma("unroll") for (int d = 0; d < 8; ++d) { const LAS unsigned char* vp = Vs + (16 * d + r16) * 144 + 64 * ks2 + 8 * g; \
                const u32x2 lo = *(const LAS u32x2*)vp, hi = *(const LAS u32x2*)(vp + 32); const u32x4 vv = {lo.x, lo.y, hi.x, hi.y}; \
                o[d] = mfma16(__builtin_bit_cast(bf16x8, vv), pb, o[d]); } } } while (0)
#define MOBA_STEP(i_, kr_, vr_) do { if ((i_) < ntiles) { MOBA_BAR(); MOBA_PUT(kr_, vr_); MOBA_BAR(); if ((i_) + 4 < ntiles) MOBA_LOAD((i_) + 4, kr_, vr_); MOBA_COMPUTE(i_); } } while (0)
    MOBA_LOAD(0, kA, vA); MOBA_LOAD(1, kB, vB);
    if (ntiles > 2) MOBA_LOAD(2, kC, vC);
    if (ntiles > 3) MOBA_LOAD(3, kD, vD);
#pragma unroll 1
    for (int it = 0; it < ntiles; it += 4) { MOBA_STEP(it, kA, vA); MOBA_STEP(it + 1, kB, vB); MOBA_STEP(it + 2, kC, vC); MOBA_STEP(it + 3, kD, vD); }
#undef MOBA_BAR
#undef MOBA_KEY0
#undef MOBA_LOAD
#undef MOBA_PUT
#undef MOBA_COMPUTE
#undef MOBA_STEP
    lq += __shfl_xor(lq, 16); lq += __shfl_xor(lq, 32);
    { const float inv = 1.0f / lq; bf16_t* op = YA + (tok0 + qpos) * 2048 + h * 128 + 4 * g;
#pragma unroll
        for (int d = 0; d < 8; ++d) { u32x2 w; w.x = cvt_pk_bf16(o[d][0] * inv, o[d][1] * inv); w.y = cvt_pk_bf16(o[d][2] * inv, o[d][3] * inv); *(u32x2*)(op + 16 * d) = w; } }
}

__device__ __forceinline__ void cross_unit(LAS unsigned char* lds, int b, int hd, int qt, const bf16_t* QC, const bf16_t* KC, const bf16_t* VCt, bf16_t* OC, int tid, int wave, int lane) {
    const int r16 = lane & 15, g = lane >> 4;
    LAS unsigned char* RA = lds;
    LAS unsigned char* Pc = lds + 67584 + wave * 8448;
    const size_t tokq = (size_t)b * SEQ + qt * 128 + wave * 16;
    bf16x8 qf[16];
    { const bf16_t* qp = QC + (tokq + r16) * D + hd * 512 + 8 * g;
#pragma unroll
        for (int ks = 0; ks < 16; ++ks) qf[ks] = __builtin_nontemporal_load((const bf16x8*)(qp + 32 * ks)); }
    f32x4 s[16];
    u32x4 pre[8];
#define CR_LOADK(kt_) do { _Pragma("unroll") for (int i = 0; i < 8; ++i) { const int idx = tid + 512 * i; pre[i] = *(const u32x4*)(KC + (size_t)(b * 256 + 64 * (kt_) + (idx >> 6)) * D + hd * 512 + 8 * (idx & 63)); } } while (0)
#define CR_LOADV(dc_) do { _Pragma("unroll") for (int i = 0; i < 8; ++i) { const int idx = tid + 512 * i; pre[i] = *(const u32x4*)(VCt + (size_t)(hd * 512 + 128 * (dc_) + (idx >> 5)) * MEMT + b * 256 + 8 * (idx & 31)); } } while (0)
    CR_LOADK(0);
#pragma unroll
    for (int kt = 0; kt < 4; ++kt) {
        __syncthreads();
#pragma unroll
        for (int i = 0; i < 8; ++i) { const int idx = tid + 512 * i; *(LAS u32x4*)(RA + (idx >> 6) * 1040 + (idx & 63) * 16) = pre[i]; }
        __syncthreads();
        if (kt < 3) CR_LOADK(kt + 1); else CR_LOADV(0);
#pragma unroll
        for (int sub = 0; sub < 4; ++sub) { f32x4 a = (f32x4){0.f, 0.f, 0.f, 0.f};
#pragma unroll
            for (int ks = 0; ks < 16; ++ks) { const bf16x8 kb = *(const LAS bf16x8*)(RA + (16 * sub + r16) * 1040 + 64 * ks + 16 * g); a = mfma16(qf[ks], kb, a); }
            s[4 * kt + sub] = a; }
    }
#pragma unroll
    for (int r = 0; r < 4; ++r) { float mx = -1e30f;
#pragma unroll
        for (int t = 0; t < 16; ++t) mx = fmaxf(mx, s[t][r]);
#pragma unroll
        for (int off = 1; off < 16; off <<= 1) mx = fmaxf(mx, __shfl_xor(mx, off));
        float ps = 0.f;
#pragma unroll
        for (int t = 0; t < 16; ++t) { const float p = __expf(s[t][r] - mx); s[t][r] = p; ps += p; }
#pragma unroll
        for (int off = 1; off < 16; off <<= 1) ps += __shfl_xor(ps, off);
        const float inv = 1.0f / ps;
#pragma unroll
        for (int t = 0; t < 16; ++t) *(LAS unsigned short*)(Pc + (4 * g + r) * 528 + (16 * t + r16) * 2) = f2bf_sw(s[t][r] * inv);
    }
#pragma unroll 1
    for (int dc = 0; dc < 4; ++dc) {
        __syncthreads();
#pragma unroll
        for (int i = 0; i < 8; ++i) { const int idx = tid + 512 * i; *(LAS u32x4*)(RA + (idx >> 5) * 528 + (idx & 31) * 16) = pre[i]; }
        __syncthreads();
        if (dc < 3) CR_LOADV(dc + 1);
        f32x4 o[8];
#pragma unroll
        for (int d = 0; d < 8; ++d) o[d] = (f32x4){0.f, 0.f, 0.f, 0.f};
#pragma unroll
        for (int ks2 = 0; ks2 < 8; ++ks2) { const bf16x8 pa = *(const LAS bf16x8*)(Pc + r16 * 528 + 64 * ks2 + 16 * g);
#pragma unroll
            for (int d = 0; d < 8; ++d) { const bf16x8 vb = *(const LAS bf16x8*)(RA + (16 * d + r16) * 528 + 64 * ks2 + 16 * g); o[d] = mfma16(vb, pa, o[d]); } }
        { bf16_t* op = OC + (tokq + r16) * D + hd * 512 + 128 * dc + 4 * g;
#pragma unroll
            for (int d = 0; d < 8; ++d) { u32x2 w; w.x = cvt_pk_bf16(o[d][0], o[d][1]); w.y = cvt_pk_bf16(o[d][2], o[d][3]); *(u32x2*)(op + 16 * d) = w; } }
    }
#undef CR_LOADK
#undef CR_LOADV
}

#define RLX_AGENT __ATOMIC_RELAXED, __HIP_MEMORY_SCOPE_AGENT
#define XB_TMO      128
#define XB_XCNT(j)  (256  + 64 * (j))
#define XB_XSUB(j)  (1280 + 64 * (j))
#define XB_XGEN(j)  (2304 + 64 * (j))
#define XB_TOP      3328
#define XB_TOPGEN   3392
#define XCD_BAR_WORDS 3456
#define XB_SPIN_CAP (1u << 18)

__device__ __forceinline__ unsigned xb_ld(unsigned* p)              { return __hip_atomic_load(p, __ATOMIC_RELAXED, __HIP_MEMORY_SCOPE_AGENT); }
__device__ __forceinline__ unsigned xb_add(unsigned* p, unsigned v) { return __hip_atomic_fetch_add(p, v, __ATOMIC_RELAXED, __HIP_MEMORY_SCOPE_AGENT); }
__device__ __forceinline__ unsigned xb_xcc_id() { return (unsigned)__builtin_amdgcn_s_getreg((3 << 11) | 20) & 0xFu; }
#define XB_SPIN(cond, bar) do { unsigned _sp = 0; while (cond) { __builtin_amdgcn_s_sleep(1); \
    if ((++_sp & 255u) == 0u) { if (xb_ld(&(bar)[XB_TMO])) break; if (_sp > XB_SPIN_CAP) { atomicAdd(&(bar)[XB_TMO], 1u); break; } } } } while (0)

struct XcdBarrier {
    unsigned* bar; unsigned x;
    volatile LAS unsigned* st;
};

__device__ __forceinline__ XcdBarrier xcd_barrier_post(unsigned* bar, volatile LAS unsigned* st) {
    XcdBarrier b; b.bar = bar; b.x = xb_xcc_id(); b.st = st;
    if (threadIdx.x == 0) (void)xb_add(&bar[XB_XCNT(b.x)], 1u);
    return b;
}
__device__ __forceinline__ void xcd_barrier_complete(unsigned* bar, unsigned x, unsigned& nloc, unsigned& nx) {
    const unsigned G = gridDim.x * gridDim.y * gridDim.z;
    unsigned sum, cnt, mine, sp = 0u;
    for (;;) {
        sum = 0u; cnt = 0u; mine = 0u;
#pragma unroll
        for (unsigned j = 0; j < 16; ++j) { const unsigned c = xb_ld(&bar[XB_XCNT(j)]); sum += c; cnt += (c > 0u) ? 1u : 0u; mine = (j == x) ? c : mine; }
        if (sum == G) break;
        __builtin_amdgcn_s_sleep(1);
        if ((++sp & 255u) == 0u) { if (xb_ld(&bar[XB_TMO])) break; if (sp > XB_SPIN_CAP) { atomicAdd(&bar[XB_TMO], 1u); break; } }
    }
    nloc = mine > 0u ? mine : 1u; nx = cnt > 0u ? cnt : 1u;
}

__device__ __forceinline__ void xcd_barrier(const XcdBarrier& b) {
    asm volatile("s_waitcnt vmcnt(0)" ::: "memory");
    __syncthreads();
    if (threadIdx.x == 0) {
        unsigned* bar = b.bar;
        __builtin_amdgcn_s_waitcnt(0);
        unsigned nloc = b.st[0], nx = b.st[1];
        if (nloc == 0u) { xcd_barrier_complete(bar, b.x, nloc, nx); b.st[0] = nloc; b.st[1] = nx; }
        const unsigned old = xb_add(&bar[XB_XSUB(b.x)], 1u);
        const unsigned gen = old / nloc;
        if (old + 1u == (gen + 1u) * nloc) {
            __builtin_amdgcn_fence(__ATOMIC_RELEASE, "agent");
            asm volatile("s_waitcnt vmcnt(0)" ::: "memory");
            const unsigned og = xb_add(&bar[XB_TOP], 1u);
            const unsigned tg = og / nx;
            if (og + 1u == (tg + 1u) * nx) xb_add(&bar[XB_TOPGEN], 1u);
            else XB_SPIN(xb_ld(&bar[XB_TOPGEN]) == tg, bar);
            __builtin_amdgcn_fence(__ATOMIC_ACQUIRE, "agent");
            xb_add(&bar[XB_XGEN(b.x)], 1u);
            asm volatile("s_waitcnt vmcnt(0)" ::: "memory");
        } else {
            XB_SPIN(xb_ld(&bar[XB_XGEN(b.x)]) == gen, bar);
            __builtin_amdgcn_fence(__ATOMIC_ACQUIRE, "agent");
            asm volatile("s_waitcnt vmcnt(0)" ::: "memory");
        }
    }
    __syncthreads();
}

__global__ void __launch_bounds__(512, 2) fwd(Args a) {
    extern __shared__ __attribute__((aligned(16))) unsigned char lds_raw[];
    LAS unsigned char* lds = (LAS unsigned char*)lds_raw;
    cg::grid_group grid = cg::this_grid();
    const int tid = threadIdx.x, lane = tid & 63, wave = __builtin_amdgcn_readfirstlane(tid >> 6);
    const int G = gridDim.x, bx = blockIdx.x;
    const int lo = a.lo, hi = a.hi;
    const int vcu = (G % 8 == 0) ? (bx % 8) * (G / 8) + bx / 8 : bx;
    unsigned char* ws = a.ws;
    const float* x = a.in[0]; const float* mem = a.in[1]; const float* norm_mix_g = a.in[2]; const float* w_in = a.in[3]; const float* b_in = a.in[4];
    const float* conv_w = a.in[5]; const float* conv_b = a.in[6]; const float* conv_ln_g = a.in[7]; const float* conv_ln_b = a.in[8];
    const float* w_conv_out = a.in[9]; const float* w_att_out = a.in[10]; const float* w_out = a.in[11]; const float* norm_cross_g = a.in[12]; const float* norm_mem_g = a.in[13];
    const float* w_cq = a.in[14]; const float* w_ckv = a.in[15]; const float* w_co = a.in[16]; const float* norm_ffn_g = a.in[17]; const float* w_ffn_in = a.in[18]; const float* w_ffn_out = a.in[19];
    const float* norm_final_g = a.in[20];
    float* ssq1 = (float*)(ws + WS_SSQ); float* ssq2 = ssq1; float* ssq3 = ssq1; float* bias_p = (float*)(ws + WS_CTL + 128 * 1024); float* rstd0 = (float*)(ws + WS_CTL + 832 * 1024); float* ksum = (float*)(ws + WS_CTL + 512 * 1024);
    bf16_t* WIN = (bf16_t*)(ws + WS_WIN); bf16_t* WCKV = (bf16_t*)(ws + WS_WCKV); bf16_t* WCONV = (bf16_t*)(ws + WS_WCONV); bf16_t* WATT = (bf16_t*)(ws + WS_WATT);
    bf16_t* WOUT = (bf16_t*)(ws + WS_WOUT); bf16_t* WCQ = (bf16_t*)(ws + WS_WCQ); bf16_t* WCO = (bf16_t*)(ws + WS_WCO); bf16_t* WFI = (bf16_t*)(ws + WS_WFI); bf16_t* WFO = (bf16_t*)(ws + WS_WFO);
    bf16_t* Hb = (bf16_t*)(ws + WS_H); bf16_t* MN = (bf16_t*)(ws + WS_MN); bf16_t* VGLU = (bf16_t*)(ws + WS_VGLU); bf16_t* Qb = (bf16_t*)(ws + WS_Q); bf16_t* Kb = (bf16_t*)(ws + WS_K);
    bf16_t* VT = (bf16_t*)(ws + WS_VT); bf16_t* SG = (bf16_t*)(ws + WS_SG); bf16_t* KC = (bf16_t*)(ws + WS_KC); bf16_t* VCT = (bf16_t*)(ws + WS_VCT);
    bf16_t* YC = (bf16_t*)(ws + WS_YC); bf16_t* YA = (bf16_t*)(ws + WS_YC) + 1024; float* PART = (float*)(ws + WS_PART); bf16_t* MERGED = (bf16_t*)(ws + WS_MERGED);
    bf16_t* X1B = (bf16_t*)(ws + WS_X1B); bf16_t* QC = (bf16_t*)(ws + WS_QC); bf16_t* OC = (bf16_t*)(ws + WS_OC); bf16_t* X2B = (bf16_t*)(ws + WS_X2B); bf16_t* ACT = (bf16_t*)(ws + WS_ACT);
    float* out = a.out;
    pg8::bf16_t* const nullb = nullptr; (void)nullb;
#define IN(k) (lo <= (k) && (k) < hi)
#if !MK_SPLIT && !defined(MK_CGSYNC)
    volatile LAS unsigned* bst = (volatile LAS unsigned*)(lds + LDS_BYTES - 16);
    if (tid < 2) bst[tid] = 0u;
    __syncthreads();
    if (bx == 0) { unsigned* cw = (unsigned*)(ws + WS_CTL + 768 * 1024);
        for (int i = tid; i < (16384 + 8192) / 4; i += 512) __hip_atomic_store(cw + i, 0u, __ATOMIC_RELAXED, __HIP_MEMORY_SCOPE_AGENT);
        asm volatile("s_waitcnt vmcnt(0)" ::: "memory"); }
    grid.sync();
    XcdBarrier xbar = xcd_barrier_post((unsigned*)(ws + WS_CTL + 768 * 1024), bst);
#endif
#ifdef DBG_TA
    unsigned long long* stamps = (unsigned long long*)(ws + WS_CTL + 256 * 1024);
#define STAMP(k) do { if (bx == 0 && tid == 0) stamps[k] = __builtin_amdgcn_s_memrealtime(); } while (0)
#else
#define STAMP(k) do { } while (0)
#endif
    STAMP(0);
#if !MK_SPLIT && !defined(MK_CGSYNC)
#define SEAM(k) do { if (IN(k) && IN((k) + 1)) xcd_barrier(xbar); STAMP((k) + 1); } while (0)
#else
#define SEAM(k) do { if (IN(k) && IN((k) + 1)) grid.sync(); STAMP((k) + 1); } while (0)
#endif

    constexpr int I0 = 32 * 144, I1 = 32 * 64, I2 = 16 * 32, I3 = 16 * 32, I4 = 32 * 32, I5 = 32 * 32, I6 = 32 * 32, I7 = 32 * 176, I8 = 88 * 32;
    constexpr int NITA = I0 + I1, NITB = I2 + I3 + I4 + I5 + I6 + I7 + I8;
#define TRA_LOAD(it_, v_) do { int r = (it_); \
            if (r < I1) { tr_load(w_ckv, 4096, r, lane, v_); break; } r -= I1; \
            tr_load(w_in, 9216, r, lane, v_); } while (0)
#define TRA_PROC(it_, v_) do { int r = (it_); \
            if (r < I1) { tr_proc(v_, D, 4096, WCKV, 0, nullptr, scr, r, lane); break; } r -= I1; \
            tr_proc(v_, D, 9216, WIN, 1, norm_mix_g, scr, r, lane); } while (0)
#define TRB_LOAD(it_, v_) do { int r = (it_); \
            if (r < I8) { tr_load(w_ffn_out, D, r, lane, v_); break; } r -= I8; \
            if (r < I7) { tr_load(w_ffn_in, 2 * DFF, r, lane, v_); break; } r -= I7; \
            if (r < I6) { tr_load(w_co, D, r, lane, v_); break; } r -= I6; \
            if (r < I5) { tr_load(w_cq, D, r, lane, v_); break; } r -= I5; \
            if (r < I4) { tr_load(w_out, D, r, lane, v_); break; } r -= I4; \
            if (r < I3) { tr_load(w_att_out, D, r, lane, v_); break; } r -= I3; \
            tr_load(w_conv_out, D, r, lane, v_); } while (0)
#define TRB_PROC(it_, v_) do { int r = (it_); \
            if (r < I8) { tr_proc(v_, DFF, D, WFO, 0, nullptr, scr, r, lane, true); break; } r -= I8; \
            if (r < I7) { tr_proc(v_, D, 2 * DFF, WFI, 2, norm_ffn_g, scr, r, lane, true); break; } r -= I7; \
            if (r < I6) { tr_proc(v_, D, D, WCO, 0, nullptr, scr, r, lane, true); break; } r -= I6; \
            if (r < I5) { tr_proc(v_, D, D, WCQ, 0, norm_cross_g, scr, r, lane, true); break; } r -= I5; \
            if (r < I4) { tr_proc(v_, D, D, WOUT, 0, nullptr, scr, r, lane, true); break; } r -= I4; \
            if (r < I3) { tr_proc(v_, 2048, D, WCONV + 1024, 0, nullptr, scr, r, lane); break; } r -= I3; \
            tr_proc(v_, 2048, D, WCONV, 0, nullptr, scr, r, lane); } while (0)
#define TR_RUN(LOAD_, PROC_, first_, stride_, total_) do { f32x4 va[16], vb[16]; int it = (first_); \
          if (it < (total_)) LOAD_(it, va); \
          while (it < (total_)) { \
              const int n1 = it + (stride_); if (n1 < (total_)) LOAD_(n1, vb); \
              PROC_(it, va); \
              const int n2 = n1 + (stride_); if (n2 < (total_)) LOAD_(n2, va); \
              if (n1 < (total_)) PROC_(n1, vb); \
              it = n2; } } while (0)
    if (IN(0)) {
        LAS float* scr = (LAS float*)(lds + wave * 16640);
        const int gw = bx * 8 + wave, NGW = G * 8;
        TR_RUN(TRB_LOAD, TRB_PROC, gw, NGW, NITB);
        TR_RUN(TRA_LOAD, TRA_PROC, gw, NGW, NITA);
        for (int m = gw; m < T; m += NGW) xb_row(x + (size_t)m * D, Hb + (size_t)m * D, rstd0 + m, lane);
        for (int m = gw; m < MEMT; m += NGW) rms_row_bf16(mem + (size_t)m * D, norm_mem_g, MN + (size_t)m * D, lane);
        for (int i = bx * 512 + tid; i < 9216; i += G * 512) bias_p[map_win(i)] = b_in[i];
    }
    SEAM(0);
    if (IN(1)) {
        { pg8::Gemm gm{Hb, WIN, T, 8192, D}; pg8::StaticOrder S; S.init(T, 8192, G, bx);
          pg8::EpiProj E{VGLU, Qb, (WS_K - WS_Q) / 2, (WS_SG - WS_Q) / 2, bias_p, ksum, rstd0};
          pg8::gemm_phase<pg8::EpiProj, pg8::StaticOrder, true, true>(lds, gm, S, E); }
#pragma unroll 1
        for (int gi = 0; gi < 3; ++gi) {
            const size_t offA = gi == 0 ? WS_WIN + (size_t)8192 * D * 2 : (gi == 1 ? WS_MN : WS_WCKV + (size_t)2048 * D * 2);
            const size_t offB = gi == 0 ? WS_H : (gi == 1 ? WS_WCKV : WS_MN);
            const size_t offO = gi == 0 ? WS_VT : (gi == 1 ? WS_KC : WS_VCT);
            const int gM = gi == 0 ? 1024 : (gi == 1 ? MEMT : 2048), gN = gi == 0 ? T : (gi == 1 ? 2048 : MEMT), shift = gi == 0 ? 0 : (gi == 1 ? 128 : 160);
            pg8::Gemm gm{(const bf16_t*)(ws + offA), (const bf16_t*)(ws + offB), gM, gN, D};
            pg8::EpiPlain E{(bf16_t*)(ws + offO), gN, bias_p + 8192, gi == 0 ? 1 : 0, rstd0};
            pg8::StaticOrder S; S.init(gM, gN, G, (bx + G - (shift % G)) % G);
            pg8::gemm_phase<pg8::EpiPlain, pg8::StaticOrder, true, true>(lds, gm, S, E);
        }
    }
    SEAM(1);
    if (IN(2)) {
#ifdef DBG_CONV2
        for (int rep = 0; rep < DBG_CONV2; ++rep)
#endif
        for (int t = vcu; t < T / 16; t += G) conv_unit(lds, t, VGLU, conv_w, conv_b, conv_ln_g, conv_ln_b, YC, tid, wave, lane);
#ifdef DBG_MOBA2
        for (int rep = 0; rep < DBG_MOBA2; ++rep)
#endif
        for (int c = vcu; c < 256; c += G) { const int bh = c >> 3, qa = c & 7;
            moba_unit(lds, bh >> 3, bh & 7, 15 - qa, Qb, Kb, VT, ksum, YA, tid, wave, lane);
            moba_unit(lds, bh >> 3, bh & 7, qa, Qb, Kb, VT, ksum, YA, tid, wave, lane); }
        __syncthreads();
    }
    SEAM(2);
    if (IN(3)) {
        pg8::Gemm gm{YC, WCONV, T, D, 2048, 1024}; pg8::HalfOrder S; S.init(T, D, G, bx); pg8::EpiGateFused E{SG, MERGED};
        pg8::gemm_phase<pg8::EpiGateFused, pg8::HalfOrder, true, true>(lds, gm, S, E);
    }
    SEAM(3);
    if (IN(4)) {
        pg8::Gemm gm{MERGED, WOUT, T, D, D}; pg8::StaticOrder S; S.init(T, D, G, bx); pg8::EpiResid<true, false, true> E{nullptr, Hb, nullptr, X1B, ssq1};
        pg8::gemm_phase<pg8::EpiResid<true, false, true>, pg8::StaticOrder, true, true>(lds, gm, S, E);
    }
    SEAM(4);
    if (IN(5)) {
#ifdef DBG_ZERO_OC
        for (size_t i = (size_t)bx * 512 + tid; i < (size_t)T * D / 8; i += (size_t)G * 512) ((u32x4*)OC)[i] = (u32x4){0u, 0u, 0u, 0u};
#endif
        pg8::Gemm gm{X1B, WCQ, T, D, D}; pg8::StaticOrder S; S.init(T, D, G, bx); pg8::EpiRowScale E{QC, ssq1, 0.04419417382415922f};
        pg8::gemm_phase<pg8::EpiRowScale, pg8::StaticOrder, true, true>(lds, gm, S, E);
    }
    SEAM(5);
    if (IN(6)) {
        for (int c = vcu; c < 256; c += G) cross_unit(lds, c >> 6, (c >> 4) & 3, c & 15, QC, KC, VCT, OC, tid, wave, lane);
        __syncthreads();
    }
    SEAM(6);
    if (IN(7)) {
        pg8::Gemm gm{OC, WCO, T, D, D}; pg8::StaticOrder S; S.init(T, D, G, bx); pg8::EpiResid<true, false, true> E{nullptr, X1B, nullptr, X2B, ssq2};
        pg8::gemm_phase<pg8::EpiResid<true, false, true>, pg8::StaticOrder, true, true>(lds, gm, S, E);
    }
    SEAM(7);
    if (IN(8)) {
        pg8::Gemm gm{X2B, WFI, T, 2 * DFF, D}; pg8::StaticOrder S; S.init(T, 2 * DFF, G, bx); pg8::EpiSwiglu E{ACT, ssq2};
        pg8::gemm_phase<pg8::EpiSwiglu, pg8::StaticOrder, true, true>(lds, gm, S, E);
    }
    SEAM(8);
    const bool fuse_final = (G == 256) && IN(9) && IN(10);
    if (IN(9)) {
        pg8::Gemm gm{ACT, WFO, T, D, DFF}; pg8::StaticOrder S; S.init(T, D, G, bx);
        if (fuse_final) { pg8::EpiFinal E{X2B, out, ssq3, (unsigned*)(ws + WS_CTL + 784 * 1024), norm_final_g};
            pg8::gemm_phase<pg8::EpiFinal, pg8::StaticOrder, true, true>(lds, gm, S, E); }
        else { pg8::EpiResid<true, true, false> E{nullptr, X2B, out, nullptr, ssq3};
            pg8::gemm_phase<pg8::EpiResid<true, true, false>, pg8::StaticOrder, true, true>(lds, gm, S, E); }
    }
    if (!fuse_final) {
    SEAM(9);
    if (IN(10)) {
        const int gw = bx * 8 + wave, NGW = G * 8;
        for (int m = gw; m < T; m += NGW) { const float rs = rsqrtf(wave_sum(lane < 32 ? ssq3[(size_t)m * 32 + lane] : 0.f) * (1.0f / 2048.0f) + EPS); f32x4* xr = (f32x4*)(out + (size_t)m * D) + lane;
#pragma unroll
            for (int j = 0; j < 8; ++j) { const f32x4 gg = ((const f32x4*)norm_final_g)[64 * j + lane]; xr[64 * j] = xr[64 * j] * rs * gg; } }
    }
    }
#ifdef DBG_TA
    STAMP(11);
    grid.sync();
    { const float va = (float)(stamps[DBG_TA + 1] - stamps[DBG_TA]) * 0.01f, vb = (float)(stamps[DBG_TB + 1] - stamps[DBG_TB]) * 0.01f;
      if (bx == 0 && tid == 0) out[0] = va;
      for (size_t i = (size_t)(1u << 20) + (size_t)bx * 512 + tid; i < (size_t)(2u << 20); i += (size_t)G * 512) out[i] += vb; }
#endif
#undef IN
#undef SEAM
}


#ifdef DBG_STOP
__device__ __forceinline__ float dsan(unsigned short b) { float v = __uint_as_float(((unsigned)b) << 16); return (v == v && fabsf(v) < 1e30f) ? v : 1000.0f; }
__global__ void dbg_copy(unsigned char* ws, float* out) {
    const bf16_t* Qb = (const bf16_t*)(ws + WS_Q); const bf16_t* Kb = (const bf16_t*)(ws + WS_K); const bf16_t* VT = (const bf16_t*)(ws + WS_VT); const bf16_t* VG = (const bf16_t*)(ws + WS_VGLU);
    const bf16_t* SG = (const bf16_t*)(ws + WS_SG); const bf16_t* KC = (const bf16_t*)(ws + WS_KC); const bf16_t* VCT = (const bf16_t*)(ws + WS_VCT);
    const bf16_t* YC = (const bf16_t*)(ws + WS_YC); const bf16_t* YA = (const bf16_t*)(ws + WS_YA); const bf16_t* MG = (const bf16_t*)(ws + WS_MERGED);
    const bf16_t* QC = (const bf16_t*)(ws + WS_QC); const bf16_t* OC = (const bf16_t*)(ws + WS_OC); const bf16_t* ACT = (const bf16_t*)(ws + WS_ACT);
    const size_t M8 = (size_t)8 << 20, M2 = (size_t)2 << 20, M16 = (size_t)16 << 20;
    for (size_t i = (size_t)blockIdx.x * blockDim.x + threadIdx.x; i < M16; i += (size_t)gridDim.x * blockDim.x) {
        float v = 0.f;
        if (DBG_SET == 1) v = dsan(Qb[i % M8]) + dsan(Kb[i % M8]) + dsan(VT[i % M8]) + dsan(VG[i % M8]) + dsan(SG[i]) + dsan(SG[i + M16]) + dsan(KC[i % M2]) + dsan(VCT[i % M2]);
        if (DBG_SET == 2) v = dsan(YC[i % M8]) + dsan(YA[i % M8]);
        if (DBG_SET == 3) v = dsan(MG[i]);
        if (DBG_SET == 4) { const float o = out[i]; v = (o == o && fabsf(o) < 1e30f) ? o : 1000.0f; }
        if (DBG_SET == 5) v = dsan(QC[i]);
        if (DBG_SET == 6) v = dsan(OC[i]);
        if (DBG_SET == 8) v = dsan(ACT[i]) + dsan(ACT[i + M16]);
        if (DBG_SET == 60) { const float t = __uint_as_float(((unsigned)OC[i]) << 16); v = (t == t && fabsf(t) < 100.f) ? 0.f : 1000.f; }
        if (DBG_SET == 30) v = dsan(KC[i % M2]);
        if (DBG_SET == 31) v = dsan(VCT[i % M2]);
        if (DBG_SET == 20) v = dsan(YC[i % M8]);
        if (DBG_SET == 21) v = dsan(YA[i % M8]);
        out[i] = v;
    }
}
#endif
extern "C" void kernel_launch(void* const* d_in, const int* in_sizes, int n_in, void* d_out, int out_size, void* d_ws, size_t ws_size, hipStream_t stream) {
    static int grid = 0;
    if (grid == 0) {
        int dev = 0, cus = 0, per_cu = 0;
        if (n_in != 21 || ws_size < WS_END) { fprintf(stderr, "kernel_launch: n_in %d ws_size %zu (need %zu)\n", n_in, ws_size, (size_t)WS_END); grid = -1; return; }
        (void)hipGetDevice(&dev); (void)hipDeviceGetAttribute(&cus, hipDeviceAttributeMultiprocessorCount, dev);
        if (hipFuncSetAttribute((const void*)fwd, hipFuncAttributeMaxDynamicSharedMemorySize, LDS_BYTES) != hipSuccess) { fprintf(stderr, "kernel_launch: hipFuncSetAttribute failed\n"); grid = -1; return; }
        if (hipOccupancyMaxActiveBlocksPerMultiprocessor(&per_cu, (const void*)fwd, 512, LDS_BYTES) != hipSuccess || per_cu < 1) { fprintf(stderr, "kernel_launch: occupancy query gave %d\n", per_cu); per_cu = 1; }
        (void)hipGetLastError();
        grid = cus * per_cu;
        fprintf(stderr, "kernel_launch: grid %d (%d CUs x %d), ws %zu\n", grid, cus, per_cu, ws_size);
    }
    if (grid < 0) return;
    Args a{};
    for (int i = 0; i < 21; ++i) a.in[i] = (const float*)d_in[i];
    a.out = (float*)d_out; a.ws = (unsigned char*)d_ws;
#if MK_SPLIT
#ifdef DBG_STOP
    for (int ph = 0; ph < DBG_STOP; ++ph) { a.lo = ph; a.hi = ph + 1; hipLaunchKernelGGL(fwd, dim3(grid), dim3(512), LDS_BYTES, stream, a); }
    hipLaunchKernelGGL(dbg_copy, dim3(2048), dim3(256), 0, stream, (unsigned char*)d_ws, (float*)d_out);
#else
    for (int ph = 0; ph < NPHASE; ++ph) { a.lo = ph; a.hi = ph + 1; hipLaunchKernelGGL(fwd, dim3(grid), dim3(512), LDS_BYTES, stream, a);
#ifdef DBG_DOUBLE
        if (ph == DBG_DOUBLE) hipLaunchKernelGGL(fwd, dim3(grid), dim3(512), LDS_BYTES, stream, a);
#endif
    }
#endif
#else
    a.lo = 0; a.hi = NPHASE;
    void* args[] = {&a};
    hipError_t e = hipLaunchCooperativeKernel((const void*)fwd, dim3(grid), dim3(512), args, LDS_BYTES, stream);
    if (e != hipSuccess) fprintf(stderr, "cooperative launch failed: %s (grid %d)\n", hipGetErrorString(e), grid);
#endif
}
```

```cpp
#include <hip/hip_runtime.h>
#include <hip/hip_cooperative_groups.h>
#include <cstdio>
#include <cstdint>
namespace cg = cooperative_groups;
namespace pg8 {
#define PG8_LAS __attribute__((address_space(3)))
typedef unsigned short bf16_t;
typedef short bf16x8 __attribute__((ext_vector_type(8)));
typedef float f32x4 __attribute__((ext_vector_type(4)));
typedef unsigned u32x4 __attribute__((ext_vector_type(4)));
constexpr int BM = 256, BK = 64, HALF = 128, HTB = HALF * BK * 2  , STAGE_BYTES = 8 * HTB, NXCD = 8, WGM = 8;

__host__ __device__ __forceinline__ int lds_byte(int r, int c) { const int st = (r >> 4) * 2 + (c >> 5), rr = r & 15, cc = c & 31, ob = rr * 64 + cc * 2; return st * 1024 + (ob ^ (((ob >> 9) & 1) << 5)); }
__host__ __device__ __forceinline__ void stage_rc(int b, int& R, int& C) { const int st = b / 1024, sb = b % 1024, swz = sb ^ (((sb >> 9) & 1) << 5); R = (st >> 1) * 16 + swz / 64; C = (st & 1) * 32 + (swz % 64) / 2; }
__host__ __device__ __forceinline__ int perm32(int rho) { const int n = rho >> 4, i = rho & 15; return 8 * (i >> 2) + 4 * n + (i & 3); }

struct Unit { int pm, pn; int koff = 0; };
struct Gemm { const bf16_t* A; const bf16_t* Bt; int M, N, K; int klen = 0; };

struct StaticOrder {
    int nM, nN, nwg, G, c;
    __host__ __device__ void init(int M, int N, int G_, int c_) { nM = M / BM; nN = N / BM; nwg = nM * nN; G = G_; c = c_; }
    __host__ __device__ bool next(int i, Unit& u) const {
        const long L = (long)i * G + c; if (L >= nwg) return false;
        int wgid = (int)L; { const int q = nwg / NXCD, r = nwg % NXCD, xcd = wgid % NXCD, off = wgid / NXCD; wgid = (xcd < r ? xcd * (q + 1) : r * (q + 1) + (xcd - r) * q) + off; }
        const int nig = WGM * nN, gid = wgid / nig, fm = gid * WGM, gsz = (nM - fm) < WGM ? (nM - fm) : WGM;
        u.pm = fm + ((wgid % nig) % gsz); u.pn = (wgid % nig) / gsz; return true;
    }
    __device__ __forceinline__ void a_ready(const Unit&) const {}
    __device__ __forceinline__ void done(const Unit&) const {}
};

typedef __bf16 bf16x2_t __attribute__((ext_vector_type(2)));
typedef float f32x2 __attribute__((ext_vector_type(2)));
__device__ __forceinline__ unsigned cvt_pk_bf16(float lo, float hi) { const f32x2 v = {lo, hi}; const bf16x2_t r = __builtin_convertvector(v, bf16x2_t); return __builtin_bit_cast(unsigned, r); }
__device__ __forceinline__ float sigm(float x) { return __builtin_amdgcn_rcpf(1.0f + __expf(-x)); }
__device__ __forceinline__ float bflo(unsigned w) { return __uint_as_float(w << 16); }
__device__ __forceinline__ float bfhi(unsigned w) { return __uint_as_float(w & 0xffff0000u); }
__device__ __forceinline__ u32x4 pack8(const f32x4 v0, const f32x4 v1) { u32x4 w; w.x = cvt_pk_bf16(v0[0], v0[1]); w.y = cvt_pk_bf16(v0[2], v0[3]); w.z = cvt_pk_bf16(v1[0], v1[1]); w.w = cvt_pk_bf16(v1[2], v1[3]); return w; }
constexpr float RMS_EPS = 1e-6f;

struct EpiProj {
    static constexpr bool PERM = true, AFTER_DRAIN = false, INIT = false, MID = false;
    bf16_t *Vglu, *Q; size_t offK, offSG; const float* bias; float* ksum; const float* rstd0;
    __device__ __forceinline__ void operator()(const f32x4 (&acc)[2][2][4][2], const Unit& u, int wr, int wc, int fr, int fq) const {
        const int row0 = u.pm * BM + wr * 64 + fr, lc = wc * 32 + 8 * fq, bcol0 = u.pn * BM + lc;
        f32x4 bv[2][2];
#pragma unroll
        for (int bj = 0; bj < 2; ++bj)
#pragma unroll
            for (int n = 0; n < 2; ++n) bv[bj][n] = *(const f32x4*)(bias + bcol0 + bj * HALF + 4 * n);
        if (u.pn < 8) {
#pragma unroll
            for (int ai = 0; ai < 2; ++ai)
#pragma unroll
                for (int m = 0; m < 4; ++m) { bf16_t* rowp = Vglu + (size_t)(row0 + ai * HALF + m * 16) * 1024 + u.pn * 128 + lc;
                    const float r = rstd0[row0 + ai * HALF + m * 16]; f32x4 a0 = acc[ai][0][m][0] * r + bv[0][0], a1 = acc[ai][0][m][1] * r + bv[0][1], g0 = acc[ai][1][m][0] * r + bv[1][0], g1 = acc[ai][1][m][1] * r + bv[1][1];
#pragma unroll
                    for (int j = 0; j < 4; ++j) { a0[j] *= sigm(g0[j]); a1[j] *= sigm(g1[j]); }
                    *(u32x4*)rowp = pack8(a0, a1); }
        } else if (u.pn >= 16) {
            bf16_t* base = Q + offSG + (u.pn - 16) * 128 + lc;
#pragma unroll
            for (int ai = 0; ai < 2; ++ai)
#pragma unroll
                for (int m = 0; m < 4; ++m) { const int rr = row0 + ai * HALF + m * 16; const float r = rstd0[rr];
                    f32x4 R[2], SA[2];
#pragma unroll
                    for (int n = 0; n < 2; ++n) { const f32x4 gc = acc[ai][0][m][n] * r + bv[0][n], ga = acc[ai][1][m][n] * r + bv[1][n];
#pragma unroll
                        for (int j = 0; j < 4; ++j) { const float da = 1.0f + fminf(__expf(-ga[j]), 1e30f), dc = 1.0f + __expf(-gc[j]);
                            SA[n][j] = __builtin_amdgcn_rcpf(da); R[n][j] = da * __builtin_amdgcn_rcpf(dc); } }
                    *(u32x4*)(base + (size_t)rr * 4096) = pack8(R[0], R[1]); *(u32x4*)(base + (size_t)rr * 4096 + 2048) = pack8(SA[0], SA[1]); }
        } else {
            const bool sg = false, isk = u.pn >= 12 && u.pn < 16; const int colt = sg ? (u.pn - 16) * 256 : ((u.pn - 8) & 3) * 256, ldc = sg ? 4096 : 1024;
            bf16_t* base = Q + (sg ? offSG : (u.pn >= 12 ? offK : (size_t)0));
#pragma unroll
            for (int ai = 0; ai < 2; ++ai)
#pragma unroll
                for (int m = 0; m < 4; ++m) { const int rr = row0 + ai * HALF + m * 16; const float r = rstd0[rr]; bf16_t* rowp = base + (size_t)rr * ldc + colt + lc;
                    if (isk) rowp = base + ((size_t)((rr >> 11) * 8 + (u.pn - 12) * 2) * 2048 + (rr & 2047)) * 128 + lc;
#pragma unroll
                    for (int bj = 0; bj < 2; ++bj) { f32x4 v0 = acc[ai][bj][m][0] * r + bv[bj][0], v1 = acc[ai][bj][m][1] * r + bv[bj][1];
                        if (sg) {
#pragma unroll
                            for (int j = 0; j < 4; ++j) { v0[j] = sigm(v0[j]); v1[j] = sigm(v1[j]); } }
                        *(u32x4*)(rowp + (isk ? bj * (2048 * 128) : bj * HALF)) = pack8(v0, v1); } }
            if (isk) {
                float* kp = ksum + (size_t)(wr * 32 + u.pm) * 1024 + (u.pn - 12) * 256 + lc;
#pragma unroll
                for (int bj = 0; bj < 2; ++bj)
#pragma unroll
                    for (int n = 0; n < 2; ++n) { f32x4 t = bv[bj][n] * 8.0f;
#pragma unroll
                        for (int ai = 0; ai < 2; ++ai)
#pragma unroll
                            for (int m = 0; m < 4; ++m) t += acc[ai][bj][m][n] * rstd0[row0 + ai * HALF + m * 16];
#pragma unroll
                        for (int j = 0; j < 4; ++j) { float x = t[j]; x += __shfl_xor(x, 1); x += __shfl_xor(x, 2); x += __shfl_xor(x, 4); x += __shfl_xor(x, 8); t[j] = x; }
                        if (fr == 0) *(f32x4*)(kp + bj * HALF + 4 * n) = t; }
            }
        }
    }
};
struct EpiPlain {
    static constexpr bool PERM = true, AFTER_DRAIN = false, INIT = false, MID = false;
    bf16_t* O; int ldc; const float* rowbias; int has_bias; const float* colscale;
    __device__ __forceinline__ void operator()(const f32x4 (&acc)[2][2][4][2], const Unit& u, int wr, int wc, int fr, int fq) const {
        const int row0 = u.pm * BM + wr * 64 + fr, col0 = u.pn * BM + wc * 32 + 8 * fq;
#pragma unroll
        for (int ai = 0; ai < 2; ++ai)
#pragma unroll
            for (int m = 0; m < 4; ++m) { const int row = row0 + ai * HALF + m * 16; const float rb = has_bias ? rowbias[row] : 0.f; bf16_t* rowp = O + (size_t)row * ldc + col0;
#pragma unroll
                for (int bj = 0; bj < 2; ++bj) { f32x4 v0 = acc[ai][bj][m][0], v1 = acc[ai][bj][m][1]; bf16_t* dst = rowp + bj * HALF;
                    if (has_bias) { const float* cs = colscale + col0 + bj * HALF; v0 = v0 * *(const f32x4*)cs + rb; v1 = v1 * *(const f32x4*)(cs + 4) + rb; }
                    if (has_bias) { const int col = col0 + bj * HALF, tp = col & 2047; dst = O + ((((size_t)((col >> 11) * 8 + (row >> 7)) * 32 + (tp >> 6)) * 128 + (row & 127)) * 64 + (tp & 63)); }
                    *(u32x4*)dst = pack8(v0, v1); } }
    }
};
struct HalfOrder : StaticOrder {
    __host__ __device__ bool next(int i, Unit& u) const { if (!StaticOrder::next(i >> 1, u)) return false; u.koff = (i & 1) * 1024; return true; }
};
struct EpiGateFused {
    static constexpr bool PERM = true, AFTER_DRAIN = false, INIT = true, MID = false;
    const bf16_t* SG; bf16_t* MERGED;
    __device__ __forceinline__ void mid(f32x4 (&acc)[2][2][4][2], const Unit& u, int wr, int wc, int fr, int fq) const {
        const int row0 = u.pm * BM + wr * 64 + fr, col0 = u.pn * BM + wc * 32 + 8 * fq;
#pragma unroll
        for (int ai = 0; ai < 2; ++ai)
#pragma unroll
            for (int m = 0; m < 4; ++m) { const bf16_t* sp = SG + (size_t)(row0 + ai * HALF + m * 16) * 4096 + col0;
#pragma unroll
                for (int bj = 0; bj < 2; ++bj) { const u32x4 gr = __builtin_nontemporal_load((const u32x4*)(sp + bj * HALF));
                    f32x4& v0 = acc[ai][bj][m][0]; f32x4& v1 = acc[ai][bj][m][1];
                    v0[0] *= bflo(gr.x); v0[1] *= bfhi(gr.x); v0[2] *= bflo(gr.y); v0[3] *= bfhi(gr.y); v1[0] *= bflo(gr.z); v1[1] *= bfhi(gr.z); v1[2] *= bflo(gr.w); v1[3] *= bfhi(gr.w); }
            }
    }
    __device__ __forceinline__ void init(f32x4 (&acc)[2][2][4][2], const Unit& u, int, int, int, int) const {
        if (u.koff == 0) {
#pragma unroll
            for (int a = 0; a < 2; ++a)
#pragma unroll
                for (int b = 0; b < 2; ++b)
#pragma unroll
                    for (int m = 0; m < 4; ++m) { acc[a][b][m][0] = (f32x4){0.f, 0.f, 0.f, 0.f}; acc[a][b][m][1] = (f32x4){0.f, 0.f, 0.f, 0.f}; } }
    }
    __device__ __forceinline__ void operator()(f32x4 (&acc)[2][2][4][2], const Unit& u, int wr, int wc, int fr, int fq) const {
        if (u.koff == 0) { mid(acc, u, wr, wc, fr, fq); return; }
        const int row0 = u.pm * BM + wr * 64 + fr, col0 = u.pn * BM + wc * 32 + 8 * fq;
#pragma unroll
        for (int ai = 0; ai < 2; ++ai)
#pragma unroll
            for (int m = 0; m < 4; ++m) { const size_t row = (size_t)(row0 + ai * HALF + m * 16);
#pragma unroll
                for (int bj = 0; bj < 2; ++bj) { const int col = col0 + bj * HALF; const u32x4 ga = __builtin_nontemporal_load((const u32x4*)(SG + row * 4096 + 2048 + col));
                    f32x4 v0 = acc[ai][bj][m][0], v1 = acc[ai][bj][m][1];
                    v0[0] *= bflo(ga.x); v0[1] *= bfhi(ga.x); v0[2] *= bflo(ga.y); v0[3] *= bfhi(ga.y); v1[0] *= bflo(ga.z); v1[1] *= bfhi(ga.z); v1[2] *= bflo(ga.w); v1[3] *= bfhi(ga.w);
                    *(u32x4*)(MERGED + row * 2048 + col) = pack8(v0, v1); } }
    }
};
template <bool RB, bool WF, bool WB> struct EpiResid {
    static constexpr bool PERM = true, AFTER_DRAIN = false, INIT = true, MID = false;
    const float* resid; const bf16_t* residb; float* out; bf16_t* xb; float* ssq;
    __device__ __forceinline__ void init(f32x4 (&acc)[2][2][4][2], const Unit& u, int wr, int wc, int fr, int fq) const {
        const int row0 = u.pm * BM + wr * 64 + fr, col0 = u.pn * BM + wc * 32 + 8 * fq;
#pragma unroll
        for (int ai = 0; ai < 2; ++ai)
#pragma unroll
            for (int m = 0; m < 4; ++m)
#pragma unroll
                for (int bj = 0; bj < 2; ++bj) { const size_t off = (size_t)(row0 + ai * HALF + m * 16) * 2048 + col0 + bj * HALF;
                    if (RB) { const u32x4 w = __builtin_nontemporal_load((const u32x4*)(residb + off));
                        acc[ai][bj][m][0] = (f32x4){bflo(w.x), bfhi(w.x), bflo(w.y), bfhi(w.y)}; acc[ai][bj][m][1] = (f32x4){bflo(w.z), bfhi(w.z), bflo(w.w), bfhi(w.w)}; }
                    else { acc[ai][bj][m][0] = __builtin_nontemporal_load((const f32x4*)(resid + off)); acc[ai][bj][m][1] = __builtin_nontemporal_load((const f32x4*)(resid + off + 4)); } }
    }
    __device__ __forceinline__ void operator()(const f32x4 (&acc)[2][2][4][2], const Unit& u, int wr, int wc, int fr, int fq) const {
        const int row0 = u.pm * BM + wr * 64 + fr, col0 = u.pn * BM + wc * 32 + 8 * fq;
#pragma unroll
        for (int ai = 0; ai < 2; ++ai)
#pragma unroll
            for (int m = 0; m < 4; ++m) { const size_t row = (size_t)(row0 + ai * HALF + m * 16); float sq = 0.f;
#pragma unroll
                for (int bj = 0; bj < 2; ++bj) { const size_t off = row * 2048 + col0 + bj * HALF;
                    const f32x4 v0 = acc[ai][bj][m][0], v1 = acc[ai][bj][m][1];
                    if (WF) { *(f32x4*)(out + off) = v0; *(f32x4*)(out + off + 4) = v1; }
                    sq += (v0[0] * v0[0] + v0[1] * v0[1]) + (v0[2] * v0[2] + v0[3] * v0[3]) + (v1[0] * v1[0] + v1[1] * v1[1]) + (v1[2] * v1[2] + v1[3] * v1[3]);
                    if (WB) *(u32x4*)(xb + off) = pack8(v0, v1); }
                sq += __shfl_xor(sq, 16); sq += __shfl_xor(sq, 32);
                if (fq == 0) ssq[row * 32 + u.pn * 4 + wc] = sq; }
    }
};

struct EpiFinal {
    static constexpr bool PERM = true, AFTER_DRAIN = false, INIT = true, MID = false;
    const bf16_t* residb; float* out; float* ssq; unsigned* cnt; const float* gfin;
    __device__ __forceinline__ void init(f32x4 (&acc)[2][2][4][2], const Unit& u, int wr, int wc, int fr, int fq) const {
        const int row0 = u.pm * BM + wr * 64 + fr, col0 = u.pn * BM + wc * 32 + 8 * fq;
#pragma unroll
        for (int ai = 0; ai < 2; ++ai)
#pragma unroll
            for (int m = 0; m < 4; ++m)
#pragma unroll
                for (int bj = 0; bj < 2; ++bj) { const size_t off = (size_t)(row0 + ai * HALF + m * 16) * 2048 + col0 + bj * HALF; const u32x4 w = __builtin_nontemporal_load((const u32x4*)(residb + off));
                    acc[ai][bj][m][0] = (f32x4){bflo(w.x), bfhi(w.x), bflo(w.y), bfhi(w.y)}; acc[ai][bj][m][1] = (f32x4){bflo(w.z), bfhi(w.z), bflo(w.w), bfhi(w.w)}; }
    }
    __device__ __forceinline__ void operator()(const f32x4 (&acc)[2][2][4][2], const Unit& u, int wr, int wc, int fr, int fq) const {
        const int row0 = u.pm * BM + wr * 64 + fr, col0 = u.pn * BM + wc * 32 + 8 * fq;
#pragma unroll
        for (int ai = 0; ai < 2; ++ai)
#pragma unroll
            for (int m = 0; m < 4; ++m) { const size_t row = (size_t)(row0 + ai * HALF + m * 16); float sq = 0.f;
#pragma unroll
                for (int bj = 0; bj < 2; ++bj) { const f32x4 v0 = acc[ai][bj][m][0], v1 = acc[ai][bj][m][1];
                    sq += (v0[0] * v0[0] + v0[1] * v0[1]) + (v0[2] * v0[2] + v0[3] * v0[3]) + (v1[0] * v1[0] + v1[1] * v1[1]) + (v1[2] * v1[2] + v1[3] * v1[3]); }
                sq += __shfl_xor(sq, 16); sq += __shfl_xor(sq, 32);
                if (fq == 0) __hip_atomic_store(ssq + row * 32 + u.pn * 4 + wc, sq, __ATOMIC_RELAXED, __HIP_MEMORY_SCOPE_AGENT); }
        asm volatile("s_waitcnt vmcnt(0)" ::: "memory");
        unsigned* c = cnt + 64 * u.pm;
        if (fr == 0 && fq == 0) __hip_atomic_fetch_add(c, 1u, __ATOMIC_RELAXED, __HIP_MEMORY_SCOPE_AGENT);
        { unsigned sp = 0u; while ((unsigned)__builtin_amdgcn_readfirstlane(__hip_atomic_load(c, __ATOMIC_RELAXED, __HIP_MEMORY_SCOPE_AGENT)) < 64u) { __builtin_amdgcn_s_sleep(2); if (++sp > (1u << 20)) break; } }
        __builtin_amdgcn_fence(__ATOMIC_ACQUIRE, "agent");
#pragma unroll
        for (int ai = 0; ai < 2; ++ai)
#pragma unroll
            for (int m = 0; m < 4; ++m) { const size_t row = (size_t)(row0 + ai * HALF + m * 16); const float* sp = ssq + row * 32 + fq * 8; float t = 0.f;
#pragma unroll
                for (int i = 0; i < 8; ++i) t += __hip_atomic_load(sp + i, __ATOMIC_RELAXED, __HIP_MEMORY_SCOPE_AGENT);
                t += __shfl_xor(t, 16); t += __shfl_xor(t, 32);
                const float rs = rsqrtf(t * (1.0f / 2048.0f) + RMS_EPS);
#pragma unroll
                for (int bj = 0; bj < 2; ++bj) { const int col = col0 + bj * HALF; const size_t off = row * 2048 + col;
                    const f32x4 g0 = *(const f32x4*)(gfin + col), g1 = *(const f32x4*)(gfin + col + 4);
                    __builtin_nontemporal_store(acc[ai][bj][m][0] * rs * g0, (f32x4*)(out + off)); __builtin_nontemporal_store(acc[ai][bj][m][1] * rs * g1, (f32x4*)(out + off + 4)); } }
    }
};
__device__ __forceinline__ float row_ssq(const float* ssq, size_t row, int fq) {
    const float* sp = ssq + row * 32 + fq * 8; const f32x4 a = *(const f32x4*)sp, b = *(const f32x4*)(sp + 4);
    float s = ((a[0] + a[1]) + (a[2] + a[3])) + ((b[0] + b[1]) + (b[2] + b[3]));
    s += __shfl_xor(s, 16); s += __shfl_xor(s, 32); return s;
}
struct EpiRowScale {
    static constexpr bool PERM = true, AFTER_DRAIN = false, INIT = false, MID = false;
    bf16_t* O; const float* ssq; float mul;
    __device__ __forceinline__ void operator()(const f32x4 (&acc)[2][2][4][2], const Unit& u, int wr, int wc, int fr, int fq) const {
        const int row0 = u.pm * BM + wr * 64 + fr, col0 = u.pn * BM + wc * 32 + 8 * fq;
#pragma unroll
        for (int ai = 0; ai < 2; ++ai)
#pragma unroll
            for (int m = 0; m < 4; ++m) { const size_t row = (size_t)(row0 + ai * HALF + m * 16); const float rs = rsqrtf(row_ssq(ssq, row, fq) * (1.0f / 2048.0f) + RMS_EPS) * mul;
#pragma unroll
                for (int bj = 0; bj < 2; ++bj) *(u32x4*)(O + row * 2048 + col0 + bj * HALF) = pack8(acc[ai][bj][m][0] * rs, acc[ai][bj][m][1] * rs); }
    }
};
struct EpiSwiglu {
    static constexpr bool PERM = true, AFTER_DRAIN = false, INIT = false, MID = false;
    bf16_t* ACT; const float* ssq;
    __device__ __forceinline__ void operator()(const f32x4 (&acc)[2][2][4][2], const Unit& u, int wr, int wc, int fr, int fq) const {
        const int row0 = u.pm * BM + wr * 64 + fr, lc = wc * 32 + 8 * fq;
#pragma unroll
        for (int ai = 0; ai < 2; ++ai)
#pragma unroll
            for (int m = 0; m < 4; ++m) { const size_t row = (size_t)(row0 + ai * HALF + m * 16); const float rs = rsqrtf(row_ssq(ssq, row, fq) * (1.0f / 2048.0f) + RMS_EPS);
                f32x4 g0 = acc[ai][0][m][0] * rs, g1 = acc[ai][0][m][1] * rs, u0 = acc[ai][1][m][0] * rs, u1 = acc[ai][1][m][1] * rs;
#pragma unroll
                for (int j = 0; j < 4; ++j) { g0[j] = g0[j] * sigm(g0[j]) * u0[j]; g1[j] = g1[j] * sigm(g1[j]) * u1[j]; }
                *(u32x4*)(ACT + row * 5632 + u.pn * 128 + lc) = pack8(g0, g1); }
    }
};

template <class Epi, class Sched, bool ALIGN_EPI = false, bool SP2 = false>
__device__ __forceinline__ void gemm_phase(PG8_LAS unsigned char* lds, const Gemm g, const Sched& S, const Epi& E) {
    const int tid = threadIdx.x, wid = __builtin_amdgcn_readfirstlane(tid >> 6), lane = tid & 63, wr = wid >> 2, wc = wid & 3, fr = lane & 15, fq = lane >> 4;
    const int K = g.K, nt = (g.klen ? g.klen : K) / BK;
    unsigned voffA[2], voffB[2];
#pragma unroll
    for (int i = 0; i < 2; ++i) { int R, C; stage_rc(tid * 16 + i * 8192, R, C); const int Rb = Epi::PERM ? ((R & ~31) + perm32(R & 31)) : R;
        voffA[i] = (unsigned)(R * K + C) * 2u; voffB[i] = (unsigned)(Rb * K + C) * 2u; }
    const size_t kstep = (size_t)(BK * 2);
    const size_t hstep = (size_t)HALF * K * 2;
    const size_t tstep = 2 * hstep;
    const unsigned ldsw = (unsigned)wid * 1024u;
    const int aoff = lds_byte(wr * 64 + fr, fq * 8), boff = lds_byte(wc * 32 + fr, fq * 8);
#define PG8_SA(b, h) (((b) * 2 + (h)) * HTB)
#define PG8_SB(b, h) ((4 + (b) * 2 + (h)) * HTB)
#define PG8_STAGE(bufoff, gbase, voff) do { _Pragma("unroll") for (int _i = 0; _i < 2; ++_i) \
        __builtin_amdgcn_global_load_lds((const unsigned*)((const char*)(gbase) + (voff)[_i]), (PG8_LAS unsigned*)(lds + (bufoff) + ldsw + _i * 8192), 16, 0, 0); } while (0)
#define PG8_LDA(dst, b, h) do { _Pragma("unroll") for (int m = 0; m < 4; ++m) _Pragma("unroll") for (int k = 0; k < 2; ++k) dst[m][k] = *(const PG8_LAS bf16x8*)(lds + PG8_SA(b, h) + aoff + m * 2048 + k * 1024); } while (0)
#define PG8_LDB(dst, b, h) do { _Pragma("unroll") for (int n = 0; n < 2; ++n) _Pragma("unroll") for (int k = 0; k < 2; ++k) dst[n][k] = *(const PG8_LAS bf16x8*)(lds + PG8_SB(b, h) + boff + n * 2048 + k * 1024); } while (0)
#define PG8_MMA(ai, bj, At, Bt) do { __builtin_amdgcn_s_setprio(1); _Pragma("unroll") for (int m = 0; m < 4; ++m) _Pragma("unroll") for (int n = 0; n < 2; ++n) _Pragma("unroll") for (int k = 0; k < 2; ++k) \
        acc[ai][bj][m][n] = __builtin_amdgcn_mfma_f32_16x16x32_bf16(Bt[n][k], At[m][k], acc[ai][bj][m][n], 0, 0, 0); __builtin_amdgcn_s_setprio(0); } while (0)
#define PG8_WAIT_V(n) asm volatile("s_waitcnt vmcnt(" #n ")" ::: "memory")
#define PG8_WAIT_L(n) asm volatile("s_waitcnt lgkmcnt(" #n ")" ::: "memory")
#define PG8_BAR __builtin_amdgcn_s_barrier()
#define PG8_SCHED __builtin_amdgcn_sched_barrier(0)
    Unit cur, nxt; int ui = 0;
    if (!S.next(0, cur)) return;
    f32x4 acc[2][2][4][2];
    if constexpr (Epi::INIT) E.init(acc, cur, wr, wc, fr, fq);
    else {
#pragma unroll
    for (int a = 0; a < 2; ++a)
#pragma unroll
        for (int b = 0; b < 2; ++b)
#pragma unroll
            for (int m = 0; m < 4; ++m)
#pragma unroll
                for (int n = 0; n < 2; ++n) acc[a][b][m][n] = (f32x4){0.f, 0.f, 0.f, 0.f};
    }
    bf16x8 At[4][2], B0[2][2], B1[2][2];
    const char* cA = (const char*)g.A + (size_t)cur.pm * tstep + (size_t)cur.koff * 2; const char* cB = (const char*)g.Bt + (size_t)cur.pn * tstep + (size_t)cur.koff * 2;
    S.a_ready(cur);
    if constexpr (SP2) {
        PG8_STAGE(PG8_SB(0, 0), cB, voffB); PG8_STAGE(PG8_SB(0, 1), cB + hstep, voffB); PG8_STAGE(PG8_SA(0, 0), cA, voffA); PG8_STAGE(PG8_SA(0, 1), cA + hstep, voffA);
        if (wr == 1) PG8_BAR;
        PG8_WAIT_V(2); PG8_BAR;
        PG8_STAGE(PG8_SB(1, 0), cB + kstep, voffB); PG8_STAGE(PG8_SA(1, 0), cA + kstep, voffA); PG8_STAGE(PG8_SB(1, 1), cB + hstep + kstep, voffB);
        PG8_WAIT_V(6); PG8_BAR;
    } else {
        PG8_STAGE(PG8_SB(0, 0), cB, voffB); PG8_STAGE(PG8_SA(0, 0), cA, voffA); PG8_STAGE(PG8_SB(0, 1), cB + hstep, voffB); PG8_STAGE(PG8_SA(0, 1), cA + hstep, voffA);
        if (wr == 1) PG8_BAR;
        PG8_WAIT_V(4); PG8_BAR;
        PG8_STAGE(PG8_SB(1, 0), cB + kstep, voffB); PG8_STAGE(PG8_SA(1, 0), cA + kstep, voffA); PG8_STAGE(PG8_SB(1, 1), cB + hstep + kstep, voffB);
        PG8_WAIT_V(6); PG8_BAR;
    }
    for (;;) {
        const bool has_next = S.next(ui + 1, nxt);
        const char* nA = has_next ? (const char*)g.A + (size_t)nxt.pm * tstep + (size_t)nxt.koff * 2 : cA; const char* nB = has_next ? (const char*)g.Bt + (size_t)nxt.pn * tstep + (size_t)nxt.koff * 2 : cB;
        for (int t = 0; t < nt; t += 2) {
            const bool last = (t == nt - 2);
            const char* a1 = cA + (size_t)(t + 1) * kstep;
            const char* a2 = last ? nA : cA + (size_t)(t + 2) * kstep; const char* b2 = last ? nB : cB + (size_t)(t + 2) * kstep;
            const char* a3 = a2 + kstep; const char* b3 = b2 + kstep;
            if (last && has_next) S.a_ready(nxt);
            if constexpr (SP2) {
            PG8_LDB(B0, 0, 0); PG8_LDB(B1, 0, 1); PG8_SCHED; PG8_LDA(At, 0, 0); PG8_STAGE(PG8_SA(1, 1), a1 + hstep, voffA);
            PG8_WAIT_V(8); PG8_WAIT_L(0); PG8_BAR; PG8_MMA(0, 0, At, B0); PG8_MMA(0, 1, At, B1); PG8_BAR; PG8_SCHED;
            PG8_LDA(At, 0, 1); PG8_STAGE(PG8_SB(0, 0), b2, voffB); PG8_STAGE(PG8_SB(0, 1), b2 + hstep, voffB); PG8_STAGE(PG8_SA(0, 0), a2, voffA);
            PG8_WAIT_V(8); PG8_WAIT_L(0); PG8_BAR; PG8_MMA(1, 0, At, B0); PG8_MMA(1, 1, At, B1); PG8_BAR; PG8_SCHED;
            PG8_LDB(B0, 1, 0); PG8_LDB(B1, 1, 1); PG8_SCHED; PG8_LDA(At, 1, 0); PG8_STAGE(PG8_SA(0, 1), a2 + hstep, voffA);
            PG8_WAIT_V(8); PG8_WAIT_L(0); PG8_BAR; PG8_MMA(0, 0, At, B0); PG8_MMA(0, 1, At, B1); PG8_BAR; PG8_SCHED;
            PG8_LDA(At, 1, 1); PG8_STAGE(PG8_SB(1, 0), b3, voffB); PG8_STAGE(PG8_SB(1, 1), b3 + hstep, voffB); PG8_STAGE(PG8_SA(1, 0), a3, voffA);
            PG8_WAIT_V(8); PG8_WAIT_L(0); PG8_BAR; PG8_MMA(1, 0, At, B0); PG8_MMA(1, 1, At, B1); PG8_BAR; PG8_SCHED;
            } else {
            PG8_LDB(B0, 0, 0); PG8_SCHED; PG8_LDA(At, 0, 0); PG8_STAGE(PG8_SA(1, 1), a1 + hstep, voffA);
            PG8_WAIT_L(8); PG8_BAR; PG8_WAIT_L(0); PG8_MMA(0, 0, At, B0); PG8_BAR; PG8_SCHED;
            PG8_LDB(B1, 0, 1); PG8_STAGE(PG8_SB(0, 0), b2, voffB);
            PG8_BAR; PG8_WAIT_L(0); PG8_MMA(0, 1, At, B1); PG8_BAR;
            PG8_LDA(At, 0, 1); PG8_STAGE(PG8_SA(0, 0), a2, voffA);
            PG8_BAR; PG8_WAIT_L(0); PG8_MMA(1, 0, At, B0); PG8_BAR; PG8_SCHED;
            PG8_STAGE(PG8_SB(0, 1), b2 + hstep, voffB);
            PG8_WAIT_V(6); PG8_BAR; PG8_MMA(1, 1, At, B1); PG8_BAR;
            PG8_LDB(B0, 1, 0); PG8_SCHED; PG8_LDA(At, 1, 0); PG8_STAGE(PG8_SA(0, 1), a2 + hstep, voffA);
            PG8_WAIT_L(8); PG8_BAR; PG8_WAIT_L(0); PG8_MMA(0, 0, At, B0); PG8_BAR; PG8_SCHED;
            PG8_LDB(B1, 1, 1); PG8_STAGE(PG8_SB(1, 0), b3, voffB);
            PG8_BAR; PG8_WAIT_L(0); PG8_MMA(0, 1, At, B1); PG8_BAR;
            PG8_LDA(At, 1, 1); PG8_STAGE(PG8_SA(1, 0), a3, voffA);
            PG8_BAR; PG8_WAIT_L(0); PG8_MMA(1, 0, At, B0); PG8_BAR; PG8_SCHED;
            PG8_STAGE(PG8_SB(1, 1), b3 + hstep, voffB);
            PG8_WAIT_V(6); PG8_BAR; PG8_MMA(1, 1, At, B1); PG8_BAR;
            }
        }
        if constexpr (ALIGN_EPI) { if (wr == 0) PG8_BAR; }
        if constexpr (!Epi::AFTER_DRAIN) { E(acc, cur, wr, wc, fr, fq); S.done(cur); }
        if (!has_next) break;
        if constexpr (Epi::INIT) E.init(acc, nxt, wr, wc, fr, fq);
        else {
#pragma unroll
        for (int a = 0; a < 2; ++a)
#pragma unroll
            for (int b = 0; b < 2; ++b)
#pragma unroll
                for (int m = 0; m < 4; ++m)
#pragma unroll
                    for (int n = 0; n < 2; ++n) acc[a][b][m][n] = (f32x4){0.f, 0.f, 0.f, 0.f};
        }
        cur = nxt; cA = nA; cB = nB; ++ui;
        if constexpr (ALIGN_EPI) { if (wr == 1) PG8_BAR; }
    }
    PG8_WAIT_V(0);
    if constexpr (!ALIGN_EPI) { if (wr == 0) PG8_BAR; }
    PG8_BAR;
    if constexpr (Epi::AFTER_DRAIN) { E.fused(acc, cur, wr, wc, fr, fq, lds, wid, lane); S.done(cur); }
#undef PG8_SA
#undef PG8_SB
#undef PG8_STAGE
#undef PG8_LDA
#undef PG8_LDB
#undef PG8_MMA
#undef PG8_WAIT_V
#undef PG8_WAIT_L
#undef PG8_BAR
#undef PG8_SCHED
}
}

#define LAS __attribute__((address_space(3)))
typedef unsigned short bf16_t;
typedef float f32x4 __attribute__((ext_vector_type(4)));
typedef float f32x2v __attribute__((ext_vector_type(2)));
typedef unsigned u32x4 __attribute__((ext_vector_type(4)));
typedef unsigned u32x2 __attribute__((ext_vector_type(2)));
typedef short bf16x8 __attribute__((ext_vector_type(8)));
using pg8::bflo; using pg8::bfhi; using pg8::cvt_pk_bf16; using pg8::sigm;

#ifndef MK_SPLIT
#define MK_SPLIT 0
#endif
constexpr int NPHASE = 11;
constexpr int T = 8192, D = 2048, SEQ = 2048, NB = 4, DC = 1024, DA = 1024, DFF = 5632, MEMT = 1024;
constexpr float EPS = 1e-6f;
constexpr int LDS_BYTES = 139264;
constexpr size_t MiB = 1u << 20;
constexpr size_t WS_CTL = 0;
constexpr size_t WS_SSQ = 151 * MiB;
constexpr size_t WS_WIN = 1 * MiB;
constexpr size_t WS_WCKV = 37 * MiB;
constexpr size_t WS_WCONV = 53 * MiB;
constexpr size_t WS_WATT = 57 * MiB;
constexpr size_t WS_WOUT = 61 * MiB;
constexpr size_t WS_WCQ = 69 * MiB;
constexpr size_t WS_WCO = 77 * MiB;
constexpr size_t WS_WFI = 85 * MiB;
constexpr size_t WS_WFO = 129 * MiB;
constexpr size_t WS_H = 152 * MiB;
constexpr size_t WS_MN = 184 * MiB;
constexpr size_t WS_VGLU = 188 * MiB;
constexpr size_t WS_Q = 204 * MiB, WS_K = 220 * MiB, WS_VT = 236 * MiB;
constexpr size_t WS_SG = 252 * MiB;
constexpr size_t WS_KC = 316 * MiB, WS_VCT = 320 * MiB;
constexpr size_t WS_YC = 324 * MiB, WS_YA = 340 * MiB;
constexpr size_t WS_PART = 152 * MiB;
constexpr size_t WS_MERGED = 216 * MiB;
constexpr size_t WS_X1B = 1 * MiB;
constexpr size_t WS_QC = 152 * MiB;
constexpr size_t WS_OC = 184 * MiB;
constexpr size_t WS_X2B = 216 * MiB;
constexpr size_t WS_ACT = 252 * MiB;
constexpr size_t WS_END = 356 * MiB;

struct Args { const float* in[21]; float* out; unsigned char* ws; int lo, hi; };

__device__ __forceinline__ float wave_sum(float v) {
#pragma unroll
    for (int o = 1; o < 64; o <<= 1) v += __shfl_xor(v, o);
    return v;
}
#define LDS_WAIT() asm volatile("s_waitcnt lgkmcnt(0)" ::: "memory")

__device__ __forceinline__ int map_win(int n) {
    if (n < 2048) { const int bj = n >> 10, c = n & 1023; return (c >> 7) * 256 + bj * 128 + (c & 127); }
    if (n < 4096) return n;
    if (n < 5120) return 8192 + (n - 4096);
    if (n < 7168) { const int c = n - 5120; return 4096 + (c >> 7) * 256 + (c & 127); }
    { const int c = n - 7168; return 4096 + (c >> 7) * 256 + 128 + (c & 127); }
}
__device__ __forceinline__ int map_ffn(int n) { const int bj = n >= DFF ? 1 : 0, c = n - bj * DFF; return (c >> 7) * 256 + bj * 128 + (c & 127); }
__device__ __forceinline__ void tr_load(const float* W, int N, int item, int lane, f32x4 (&v)[16]) {
    const int nblk = N >> 6, kb = item / nblk, nb = item - kb * nblk;
    const float* src = W + (size_t)(kb * 64 + (lane >> 4)) * N + nb * 64 + 4 * (lane & 15);
#pragma unroll
    for (int i = 0; i < 16; ++i) v[i] = __builtin_nontemporal_load((const f32x4*)(src + (size_t)(4 * i) * N));
}
__device__ __forceinline__ void tr_proc(const f32x4 (&v)[16], int K, int N, bf16_t* WT, int mode, const float* gain, LAS float* scr, int item, int lane, bool nts = false) {
    const int nblk = N >> 6, kb = item / nblk, nb = item - kb * nblk, k0 = kb * 64, n0 = nb * 64;
    const int c16 = lane & 15, r4 = lane >> 4;
#pragma unroll
    for (int i = 0; i < 16; ++i) { LAS float* s = scr + (4 * i + r4) * 65 + 4 * c16; s[0] = v[i][0]; s[1] = v[i][1]; s[2] = v[i][2]; s[3] = v[i][3]; }
    LDS_WAIT();
    const int c = lane & 7;
    float gk[8];
#pragma unroll
    for (int i = 0; i < 8; ++i) gk[i] = gain ? gain[k0 + 8 * c + i] : 1.0f;
#pragma unroll
    for (int j = 0; j < 8; ++j) { const int n = (lane >> 3) + 8 * j; const LAS float* s = scr + (8 * c) * 65 + n;
        u32x4 o; o.x = cvt_pk_bf16(s[0] * gk[0], s[65] * gk[1]); o.y = cvt_pk_bf16(s[130] * gk[2], s[195] * gk[3]); o.z = cvt_pk_bf16(s[260] * gk[4], s[325] * gk[5]); o.w = cvt_pk_bf16(s[390] * gk[6], s[455] * gk[7]);
        const int nn = n0 + n; const int dr = mode == 1 ? map_win(nn) : (mode == 2 ? map_ffn(nn) : nn);
        if (nts) __builtin_nontemporal_store(o, (u32x4*)(WT + (size_t)dr * K + k0 + 8 * c)); else *(u32x4*)(WT + (size_t)dr * K + k0 + 8 * c) = o; }
    LDS_WAIT();
}
__device__ __forceinline__ void xb_row(const float* xrow, bf16_t* orow, float* rstd_out, int lane) {
    const f32x4* xr = (const f32x4*)xrow + lane; f32x4 v[8]; float s = 0.f;
#pragma unroll
    for (int j = 0; j < 8; ++j) { v[j] = __builtin_nontemporal_load(xr + 64 * j); s += (v[j][0] * v[j][0] + v[j][1] * v[j][1]) + (v[j][2] * v[j][2] + v[j][3] * v[j][3]); }
    const float rstd = rsqrtf(wave_sum(s) * (1.0f / 2048.0f) + EPS);
    if (lane == 0) *rstd_out = rstd;
    u32x2* o8 = (u32x2*)orow + lane;
#pragma unroll
    for (int j = 0; j < 8; ++j) { u32x2 w; w.x = cvt_pk_bf16(v[j][0], v[j][1]); w.y = cvt_pk_bf16(v[j][2], v[j][3]); o8[64 * j] = w; }
}
__device__ __forceinline__ void rms_row_bf16(const float* xrow, const float* g, bf16_t* orow, int lane) {
    const f32x4* xr = (const f32x4*)xrow + lane; f32x4 v[8]; float s = 0.f;
#pragma unroll
    for (int j = 0; j < 8; ++j) { v[j] = __builtin_nontemporal_load(xr + 64 * j); s += (v[j][0] * v[j][0] + v[j][1] * v[j][1]) + (v[j][2] * v[j][2] + v[j][3] * v[j][3]); }
    const float rstd = rsqrtf(wave_sum(s) * (1.0f / 2048.0f) + EPS);
    u32x2* o8 = (u32x2*)orow + lane;
#pragma unroll
    for (int j = 0; j < 8; ++j) { const f32x4 gg = ((const f32x4*)g)[64 * j + lane]; u32x2 w; w.x = cvt_pk_bf16(v[j][0] * rstd * gg[0], v[j][1] * rstd * gg[1]); w.y = cvt_pk_bf16(v[j][2] * rstd * gg[2], v[j][3] * rstd * gg[3]); o8[64 * j] = w; }
}

__device__ __forceinline__ void conv_unit(LAS unsigned char* lds, int tile, const bf16_t* Vglu, const float (&w0)[31], const float (&w1)[31], const float* conv_b, const float* ln_g, const float* ln_b, bf16_t* YC, int tid, int wave, int lane) {
    constexpr int TT = 16;
    const int t0 = tile * TT, tb = t0 & (SEQ - 1), c0 = 2 * tid;
    const f32x2v bb = *(const f32x2v*)(conv_b + c0);
    float a0[TT], a1[TT];
#pragma unroll
    for (int t = 0; t < TT; ++t) { a0[t] = bb[0]; a1[t] = bb[1]; }
#pragma unroll
    for (int r = -30; r < TT; ++r) {
        const bool ok = (tb + r) >= 0;
        unsigned w = *(const unsigned*)(Vglu + (size_t)(ok ? t0 + r : t0) * DC + c0);
        w = ok ? w : 0u;
        const float v0 = bflo(w), v1 = bfhi(w);
#pragma unroll
        for (int t = 0; t < TT; ++t) { const int j = r - t + 30; if (j >= 0 && j <= 30) { a0[t] += w0[j] * v0; a1[t] += w1[j] * v1; } }
    }
    LAS float* red = (LAS float*)lds;
    LAS float* stat = (LAS float*)(lds + 65536);
    __syncthreads();
#pragma unroll
    for (int t = 0; t < TT; ++t) { red[(2 * t) * 512 + tid] = a0[t] + a1[t]; red[(2 * t + 1) * 512 + tid] = a0[t] * a0[t] + a1[t] * a1[t]; }
    __syncthreads();
#pragma unroll
    for (int q = 0; q < 4; ++q) { const int st = wave * 4 + q; float s = 0.f;
#pragma unroll
        for (int i = 0; i < 8; ++i) s += red[st * 512 + lane + 64 * i];
        s = wave_sum(s); if (lane == 0) stat[st] = s; }
    __syncthreads();
    const f32x2v lg = *(const f32x2v*)(ln_g + c0), lb = *(const f32x2v*)(ln_b + c0);
#pragma unroll
    for (int t = 0; t < TT; ++t) { const float mean = stat[2 * t] * (1.0f / DC), var = stat[2 * t + 1] * (1.0f / DC) - mean * mean, rstd = rsqrtf(fmaxf(var, 0.f) + EPS);
        const float z0 = (a0[t] - mean) * rstd * lg[0] + lb[0], z1 = (a1[t] - mean) * rstd * lg[1] + lb[1];
        *(unsigned*)(YC + (size_t)(t0 + t) * 2048 + c0) = cvt_pk_bf16(z0 * sigm(z0), z1 * sigm(z1)); }
}

__device__ __forceinline__ bf16_t f2bf_sw(float f) { return (bf16_t)(cvt_pk_bf16(f, 0.f) & 0xffffu); }
__device__ __forceinline__ f32x4 mfma16(bf16x8 a, bf16x8 b, f32x4 c) { return __builtin_amdgcn_mfma_f32_16x16x32_bf16(a, b, c, 0, 0, 0); }
__device__ __forceinline__ void moba_unit(LAS unsigned char* lds, int b, int h, int qt, const bf16_t* Q, const bf16_t* K, const bf16_t* Vt, const float* ksum, bf16_t* YA, int tid, int wave, int lane) {
    const int qb = qt >> 1, half = qt & 1, r16 = lane & 15, g = lane >> 4;
    LAS unsigned char* Ks = lds;
    LAS unsigned char* Vs = lds + 34816;
    LAS float* kmean = (LAS float*)(lds + 69632);
    LAS float* gate = (LAS float*)(lds + 73728);
    LAS unsigned* selm = (LAS unsigned*)(lds + 77824);
    const size_t tok0 = (size_t)b * SEQ;
    const int q0 = qb * 256 + half * 128;
    __syncthreads();
    if (qb > 0) {
        for (int idx = tid; idx < qb * 128; idx += 512) { const int j = idx >> 7, d = idx & 127; const size_t o = (size_t)(b * 8 + j) * 1024 + h * 128 + d;
            kmean[idx] = (ksum[o] + ksum[32 * 1024 + o]) * (1.0f / 256.0f); }
        __syncthreads();
        { const int q = tid & 127, jg = tid >> 7; const bf16_t* qp = Q + (tok0 + q0 + q) * DA + h * 128; float d0 = 0.f, d1 = 0.f;
            const LAS float* km0 = kmean + jg * 128; const LAS float* km1 = kmean + (jg + 4) * 128;
#pragma unroll 4
            for (int c = 0; c < 16; ++c) { const u32x4 w = *(const u32x4*)(qp + 8 * c); const float qv[8] = {bflo(w.x), bfhi(w.x), bflo(w.y), bfhi(w.y), bflo(w.z), bfhi(w.z), bflo(w.w), bfhi(w.w)};
#pragma unroll
                for (int i = 0; i < 8; ++i) { d0 += qv[i] * km0[8 * c + i]; d1 += qv[i] * km1[8 * c + i]; } }
            if (jg < qb) gate[q * 8 + jg] = d0;
            if (jg + 4 < qb) gate[q * 8 + jg + 4] = d1; }
        __syncthreads();
        if (tid < 128) { float gv[8];
#pragma unroll
            for (int j = 0; j < 8; ++j) gv[j] = (j < qb) ? gate[tid * 8 + j] : -__builtin_inff();
            unsigned mask = 0u; const int nsel = qb < 3 ? qb : 3;
#pragma unroll
            for (int s = 0; s < 3; ++s) if (s < nsel) { int best = -1; float bvv = 0.f;
#pragma unroll
                for (int j = 0; j < 8; ++j) { const bool cand = (j < qb) && !((mask >> j) & 1u); if (cand && (best < 0 || gv[j] > bvv)) { best = j; bvv = gv[j]; } }
                mask |= 1u << best; }
            selm[tid] = mask; }
        __syncthreads();
    }
    bf16x8 qf[4];
    { const bf16_t* qp = Q + (tok0 + q0 + wave * 16 + r16) * DA + h * 128 + 8 * g;
#pragma unroll
        for (int ks = 0; ks < 4; ++ks) qf[ks] = __builtin_nontemporal_load((const bf16x8*)(qp + 32 * ks)); }
    const int qrow = wave * 16 + r16, qpos = q0 + qrow;
    const unsigned smq = qb > 0 ? selm[qrow] : 0u;
    f32x4 o[8];
#pragma unroll
    for (int d = 0; d < 8; ++d) o[d] = (f32x4){0.f, 0.f, 0.f, 0.f};
    float mq = -1e30f, lq = 0.f;
    const int n_own = half ? 4 : 2, ntiles = n_own + 4 * qb;
    const float scale = 0.08838834764831845f;
    u32x4 kA[2], vA[2], kB[2], vB[2], kC[2], vC[2], kD[2], vD[2];
#define MOBA_BAR() do { asm volatile("s_waitcnt lgkmcnt(0)" ::: "memory"); __builtin_amdgcn_s_barrier(); asm volatile("" ::: "memory"); } while (0)
#define MOBA_KEY0(i_) (((i_) < n_own) ? (qb * 256 + (i_) * 64) : ((((i_) - n_own) >> 2) * 256 + (((i_) - n_own) & 3) * 64))
#define MOBA_LOAD(i_, kr_, vr_) do { const int k0_ = MOBA_KEY0(i_); _Pragma("unroll") for (int i = 0; i < 2; ++i) { const int idx = tid + 512 * i; \
        kr_[i] = *(const u32x4*)(K + ((size_t)(b * 8 + h) * 2048 + k0_) * 128 + 8 * idx); \
        vr_[i] = *(const u32x4*)(Vt + ((size_t)(b * 8 + h) * 32 + (k0_ >> 6)) * 8192 + 8 * idx); } } while (0)
#define MOBA_PUT(kr_, vr_) do { _Pragma("unroll") for (int i = 0; i < 2; ++i) { const int idx = tid + 512 * i; \
        *(LAS u32x4*)(Ks + (idx >> 4) * 272 + (idx & 15) * 16) = kr_[i]; *(LAS u32x4*)(Vs + (idx >> 3) * 144 + (idx & 7) * 16) = vr_[i]; } } while (0)
#define MOBA_COMPUTE(i_) do { \
        const bool own = (i_) < n_own; const int blk = own ? qb : (((i_) - n_own) >> 2); const int key0 = MOBA_KEY0(i_); \
        f32x4 st[4]; \
        _Pragma("unroll") for (int sub = 0; sub < 4; ++sub) { st[sub] = (f32x4){0.f, 0.f, 0.f, 0.f}; \
            _Pragma("unroll") for (int ks = 0; ks < 4; ++ks) { const bf16x8 kb = *(const LAS bf16x8*)(Ks + (16 * sub + r16) * 272 + 64 * ks + 16 * g); st[sub] = mfma16(kb, qf[ks], st[sub]); } } \
        const bool pastsel = ((smq >> blk) & 1u) != 0u; float mx = -1e30f; \
        _Pragma("unroll") for (int sub = 0; sub < 4; ++sub) \
            _Pragma("unroll") for (int r = 0; r < 4; ++r) { const int kpos = key0 + 16 * sub + 4 * g + r; const bool valid = own ? (kpos <= qpos) : pastsel; \
                const float v = valid ? st[sub][r] * scale : -1e30f; st[sub][r] = v; mx = fmaxf(mx, v); } \
        mx = fmaxf(mx, __shfl_xor(mx, 16)); mx = fmaxf(mx, __shfl_xor(mx, 32)); \
        const float mnew = fmaxf(mq, mx), alpha = __expf(mq - mnew); mq = mnew; float ps = 0.f; \
        _Pragma("unroll") for (int sub = 0; sub < 4; ++sub) \
            _Pragma("unroll") for (int r = 0; r < 4; ++r) { const float pv = (st[sub][r] > -1e29f) ? __expf(st[sub][r] - mnew) : 0.f; st[sub][r] = pv; ps += pv; } \
        lq = lq * alpha + ps; \
        _Pragma("unroll") for (int d = 0; d < 8; ++d) o[d] *= alpha; \
        _Pragma("unroll") for (int ks2 = 0; ks2 < 2; ++ks2) { const bf16x8 pb = __builtin_bit_cast(bf16x8, pg8::pack8(st[2 * ks2], st[2 * ks2 + 1])); \
            _Pragma("unroll") for (int d = 0; d < 8; ++d) { const LAS unsigned char* vp = Vs + (16 * d + r16) * 144 + 64 * ks2 + 8 * g; \
                const u32x2 lo = *(const LAS u32x2*)vp, hi = *(const LAS u32x2*)(vp + 32); const u32x4 vv = {lo.x, lo.y, hi.x, hi.y}; \
                o[d] = mfma16(__builtin_bit_cast(bf16x8, vv), pb, o[d]); } } } while (0)
#define MOBA_STEP(i_, kr_, vr_) do { if ((i_) < ntiles) { MOBA_BAR(); MOBA_PUT(kr_, vr_); MOBA_BAR(); if ((i_) + 4 < ntiles) MOBA_LOAD((i_) + 4, kr_, vr_); MOBA_COMPUTE(i_); } } while (0)
    MOBA_LOAD(0, kA, vA); MOBA_LOAD(1, kB, vB);
    if (ntiles > 2) MOBA_LOAD(2, kC, vC);
    if (ntiles > 3) MOBA_LOAD(3, kD, vD);
#pragma unroll 1
    for (int it = 0; it < ntiles; it += 4) { MOBA_STEP(it, kA, vA); MOBA_STEP(it + 1, kB, vB); MOBA_STEP(it + 2, kC, vC); MOBA_STEP(it + 3, kD, vD); }
#undef MOBA_BAR
#undef MOBA_KEY0
#undef MOBA_LOAD
#undef MOBA_PUT
#undef MOBA_COMPUTE
#undef MOBA_STEP
    lq += __shfl_xor(lq, 16); lq += __shfl_xor(lq, 32);
    { const float inv = 1.0f / lq; bf16_t* op = YA + (tok0 + qpos) * 2048 + h * 128 + 4 * g;
#pragma unroll
        for (int d = 0; d < 8; ++d) { u32x2 w; w.x = cvt_pk_bf16(o[d][0] * inv, o[d][1] * inv); w.y = cvt_pk_bf16(o[d][2] * inv, o[d][3] * inv); *(u32x2*)(op + 16 * d) = w; } }
}

__device__ __forceinline__ void cross_unit(LAS unsigned char* lds, int b, int hd, int qt, const bf16_t* QC, const bf16_t* KC, const bf16_t* VCt, bf16_t* OC, int tid, int wave, int lane) {
    const int r16 = lane & 15, g = lane >> 4;
    LAS unsigned char* RA = lds;
    LAS unsigned char* Pc = lds + 67584 + wave * 8448;
    const size_t tokq = (size_t)b * SEQ + qt * 128 + wave * 16;
    bf16x8 qf[16];
    { const bf16_t* qp = QC + (tokq + r16) * D + hd * 512 + 8 * g;
#pragma unroll
        for (int ks = 0; ks < 16; ++ks) qf[ks] = __builtin_nontemporal_load((const bf16x8*)(qp + 32 * ks)); }
    f32x4 s[16];
    u32x4 pre[8];
#define CR_LOADK(kt_) do { _Pragma("unroll") for (int i = 0; i < 8; ++i) { const int idx = tid + 512 * i; pre[i] = *(const u32x4*)(KC + (size_t)(b * 256 + 64 * (kt_) + (idx >> 6)) * D + hd * 512 + 8 * (idx & 63)); } } while (0)
#define CR_LOADV(dc_) do { _Pragma("unroll") for (int i = 0; i < 8; ++i) { const int idx = tid + 512 * i; pre[i] = *(const u32x4*)(VCt + (size_t)(hd * 512 + 128 * (dc_) + (idx >> 5)) * MEMT + b * 256 + 8 * (idx & 31)); } } while (0)
    CR_LOADK(0);
#pragma unroll
    for (int kt = 0; kt < 4; ++kt) {
        __syncthreads();
#pragma unroll
        for (int i = 0; i < 8; ++i) { const int idx = tid + 512 * i; *(LAS u32x4*)(RA + (idx >> 6) * 1040 + (idx & 63) * 16) = pre[i]; }
        __syncthreads();
        if (kt < 3) CR_LOADK(kt + 1); else CR_LOADV(0);
#pragma unroll
        for (int sub = 0; sub < 4; ++sub) { f32x4 a = (f32x4){0.f, 0.f, 0.f, 0.f};
#pragma unroll
            for (int ks = 0; ks < 16; ++ks) { const bf16x8 kb = *(const LAS bf16x8*)(RA + (16 * sub + r16) * 1040 + 64 * ks + 16 * g); a = mfma16(qf[ks], kb, a); }
            s[4 * kt + sub] = a; }
    }
#pragma unroll
    for (int r = 0; r < 4; ++r) { float mx = -1e30f;
#pragma unroll
        for (int t = 0; t < 16; ++t) mx = fmaxf(mx, s[t][r]);
#pragma unroll
        for (int off = 1; off < 16; off <<= 1) mx = fmaxf(mx, __shfl_xor(mx, off));
        float ps = 0.f;
#pragma unroll
        for (int t = 0; t < 16; ++t) { const float p = __expf(s[t][r] - mx); s[t][r] = p; ps += p; }
#pragma unroll
        for (int off = 1; off < 16; off <<= 1) ps += __shfl_xor(ps, off);
        const float inv = 1.0f / ps;
#pragma unroll
        for (int t = 0; t < 16; ++t) *(LAS unsigned short*)(Pc + (4 * g + r) * 528 + (16 * t + r16) * 2) = f2bf_sw(s[t][r] * inv);
    }
#pragma unroll 1
    for (int dc = 0; dc < 4; ++dc) {
        __syncthreads();
#pragma unroll
        for (int i = 0; i < 8; ++i) { const int idx = tid + 512 * i; *(LAS u32x4*)(RA + (idx >> 5) * 528 + (idx & 31) * 16) = pre[i]; }
        __syncthreads();
        if (dc < 3) CR_LOADV(dc + 1);
        f32x4 o[8];
#pragma unroll
        for (int d = 0; d < 8; ++d) o[d] = (f32x4){0.f, 0.f, 0.f, 0.f};
#pragma unroll
        for (int ks2 = 0; ks2 < 8; ++ks2) { const bf16x8 pa = *(const LAS bf16x8*)(Pc + r16 * 528 + 64 * ks2 + 16 * g);
#pragma unroll
            for (int d = 0; d < 8; ++d) { const bf16x8 vb = *(const LAS bf16x8*)(RA + (16 * d + r16) * 528 + 64 * ks2 + 16 * g); o[d] = mfma16(vb, pa, o[d]); } }
        { bf16_t* op = OC + (tokq + r16) * D + hd * 512 + 128 * dc + 4 * g;
#pragma unroll
            for (int d = 0; d < 8; ++d) { u32x2 w; w.x = cvt_pk_bf16(o[d][0], o[d][1]); w.y = cvt_pk_bf16(o[d][2], o[d][3]); *(u32x2*)(op + 16 * d) = w; } }
    }
#undef CR_LOADK
#undef CR_LOADV
}

#define RLX_AGENT __ATOMIC_RELAXED, __HIP_MEMORY_SCOPE_AGENT
#define XB_TMO      128
#define XB_XCNT(j)  (256  + 64 * (j))
#define XB_XSUB(j)  (1280 + 64 * (j))
#define XB_XGEN(j)  (2304 + 64 * (j))
#define XB_TOP      3328
#define XB_TOPGEN   3392
#define XCD_BAR_WORDS 3456
#define XB_SPIN_CAP (1u << 18)

__device__ __forceinline__ unsigned xb_ld(unsigned* p)              { return __hip_atomic_load(p, __ATOMIC_RELAXED, __HIP_MEMORY_SCOPE_AGENT); }
__device__ __forceinline__ unsigned xb_add(unsigned* p, unsigned v) { return __hip_atomic_fetch_add(p, v, __ATOMIC_RELAXED, __HIP_MEMORY_SCOPE_AGENT); }
__device__ __forceinline__ unsigned xb_xcc_id() { return (unsigned)__builtin_amdgcn_s_getreg((3 << 11) | 20) & 0xFu; }
#define XB_SPIN(cond, bar) do { unsigned _sp = 0; while (cond) { __builtin_amdgcn_s_sleep(1); \
    if ((++_sp & 255u) == 0u) { if (xb_ld(&(bar)[XB_TMO])) break; if (_sp > XB_SPIN_CAP) { atomicAdd(&(bar)[XB_TMO], 1u); break; } } } } while (0)

struct XcdBarrier {
    unsigned* bar; unsigned x;
    volatile LAS unsigned* st;
};

__device__ __forceinline__ XcdBarrier xcd_barrier_post(unsigned* bar, volatile LAS unsigned* st) {
    XcdBarrier b; b.bar = bar; b.x = xb_xcc_id(); b.st = st;
    if (threadIdx.x == 0) (void)xb_add(&bar[XB_XCNT(b.x)], 1u);
    return b;
}
__device__ __forceinline__ void xcd_barrier_complete(unsigned* bar, unsigned x, unsigned& nloc, unsigned& nx) {
    const unsigned G = gridDim.x * gridDim.y * gridDim.z;
    unsigned sum, cnt, mine, sp = 0u;
    for (;;) {
        sum = 0u; cnt = 0u; mine = 0u;
#pragma unroll
        for (unsigned j = 0; j < 16; ++j) { const unsigned c = xb_ld(&bar[XB_XCNT(j)]); sum += c; cnt += (c > 0u) ? 1u : 0u; mine = (j == x) ? c : mine; }
        if (sum == G) break;
        __builtin_amdgcn_s_sleep(1);
        if ((++sp & 255u) == 0u) { if (xb_ld(&bar[XB_TMO])) break; if (sp > XB_SPIN_CAP) { atomicAdd(&bar[XB_TMO], 1u); break; } }
    }
    nloc = mine > 0u ? mine : 1u; nx = cnt > 0u ? cnt : 1u;
}

__device__ __forceinline__ void xcd_barrier(const XcdBarrier& b) {
    asm volatile("s_waitcnt vmcnt(0)" ::: "memory");
    __syncthreads();
    if (threadIdx.x == 0) {
        unsigned* bar = b.bar;
        __builtin_amdgcn_s_waitcnt(0);
        unsigned nloc = b.st[0], nx = b.st[1];
        if (nloc == 0u) { xcd_barrier_complete(bar, b.x, nloc, nx); b.st[0] = nloc; b.st[1] = nx; }
        const unsigned old = xb_add(&bar[XB_XSUB(b.x)], 1u);
        const unsigned gen = old / nloc;
        if (old + 1u == (gen + 1u) * nloc) {
            __builtin_amdgcn_fence(__ATOMIC_RELEASE, "agent");
            asm volatile("s_waitcnt vmcnt(0)" ::: "memory");
            const unsigned og = xb_add(&bar[XB_TOP], 1u);
            const unsigned tg = og / nx;
            if (og + 1u == (tg + 1u) * nx) xb_add(&bar[XB_TOPGEN], 1u);
            else XB_SPIN(xb_ld(&bar[XB_TOPGEN]) == tg, bar);
            __builtin_amdgcn_fence(__ATOMIC_ACQUIRE, "agent");
            xb_add(&bar[XB_XGEN(b.x)], 1u);
            asm volatile("s_waitcnt vmcnt(0)" ::: "memory");
        } else {
            XB_SPIN(xb_ld(&bar[XB_XGEN(b.x)]) == gen, bar);
            __builtin_amdgcn_fence(__ATOMIC_ACQUIRE, "agent");
            asm volatile("s_waitcnt vmcnt(0)" ::: "memory");
        }
    }
    __syncthreads();
}

__global__ void __launch_bounds__(512, 2) fwd(Args a) {
    extern __shared__ __attribute__((aligned(16))) unsigned char lds_raw[];
    LAS unsigned char* lds = (LAS unsigned char*)lds_raw;
    cg::grid_group grid = cg::this_grid();
    const int tid = threadIdx.x, lane = tid & 63, wave = __builtin_amdgcn_readfirstlane(tid >> 6);
    const int G = gridDim.x, bx = blockIdx.x;
    const int lo = a.lo, hi = a.hi;
    const int vcu = (G % 8 == 0) ? (bx % 8) * (G / 8) + bx / 8 : bx;
    unsigned char* ws = a.ws;
    const float* x = a.in[0]; const float* mem = a.in[1]; const float* norm_mix_g = a.in[2]; const float* w_in = a.in[3]; const float* b_in = a.in[4];
    const float* conv_w = a.in[5]; const float* conv_b = a.in[6]; const float* conv_ln_g = a.in[7]; const float* conv_ln_b = a.in[8];
    const float* w_conv_out = a.in[9]; const float* w_att_out = a.in[10]; const float* w_out = a.in[11]; const float* norm_cross_g = a.in[12]; const float* norm_mem_g = a.in[13];
    const float* w_cq = a.in[14]; const float* w_ckv = a.in[15]; const float* w_co = a.in[16]; const float* norm_ffn_g = a.in[17]; const float* w_ffn_in = a.in[18]; const float* w_ffn_out = a.in[19];
    const float* norm_final_g = a.in[20];
    float* ssq1 = (float*)(ws + WS_SSQ); float* ssq2 = ssq1; float* ssq3 = ssq1; float* bias_p = (float*)(ws + WS_CTL + 128 * 1024); float* rstd0 = (float*)(ws + WS_CTL + 832 * 1024); float* ksum = (float*)(ws + WS_CTL + 512 * 1024);
    bf16_t* WIN = (bf16_t*)(ws + WS_WIN); bf16_t* WCKV = (bf16_t*)(ws + WS_WCKV); bf16_t* WCONV = (bf16_t*)(ws + WS_WCONV); bf16_t* WATT = (bf16_t*)(ws + WS_WATT);
    bf16_t* WOUT = (bf16_t*)(ws + WS_WOUT); bf16_t* WCQ = (bf16_t*)(ws + WS_WCQ); bf16_t* WCO = (bf16_t*)(ws + WS_WCO); bf16_t* WFI = (bf16_t*)(ws + WS_WFI); bf16_t* WFO = (bf16_t*)(ws + WS_WFO);
    bf16_t* Hb = (bf16_t*)(ws + WS_H); bf16_t* MN = (bf16_t*)(ws + WS_MN); bf16_t* VGLU = (bf16_t*)(ws + WS_VGLU); bf16_t* Qb = (bf16_t*)(ws + WS_Q); bf16_t* Kb = (bf16_t*)(ws + WS_K);
    bf16_t* VT = (bf16_t*)(ws + WS_VT); bf16_t* SG = (bf16_t*)(ws + WS_SG); bf16_t* KC = (bf16_t*)(ws + WS_KC); bf16_t* VCT = (bf16_t*)(ws + WS_VCT);
    bf16_t* YC = (bf16_t*)(ws + WS_YC); bf16_t* YA = (bf16_t*)(ws + WS_YC) + 1024; float* PART = (float*)(ws + WS_PART); bf16_t* MERGED = (bf16_t*)(ws + WS_MERGED);
    bf16_t* X1B = (bf16_t*)(ws + WS_X1B); bf16_t* QC = (bf16_t*)(ws + WS_QC); bf16_t* OC = (bf16_t*)(ws + WS_OC); bf16_t* X2B = (bf16_t*)(ws + WS_X2B); bf16_t* ACT = (bf16_t*)(ws + WS_ACT);
    float* out = a.out;
    pg8::bf16_t* const nullb = nullptr; (void)nullb;
#define IN(k) (lo <= (k) && (k) < hi)
#if !MK_SPLIT && !defined(MK_CGSYNC)
    volatile LAS unsigned* bst = (volatile LAS unsigned*)(lds + LDS_BYTES - 16);
    if (tid < 2) bst[tid] = 0u;
    __syncthreads();
    if (bx == 0) { unsigned* cw = (unsigned*)(ws + WS_CTL + 768 * 1024);
        for (int i = tid; i < (16384 + 8192) / 4; i += 512) __hip_atomic_store(cw + i, 0u, __ATOMIC_RELAXED, __HIP_MEMORY_SCOPE_AGENT);
        asm volatile("s_waitcnt vmcnt(0)" ::: "memory"); }
    grid.sync();
    XcdBarrier xbar = xcd_barrier_post((unsigned*)(ws + WS_CTL + 768 * 1024), bst);
#endif
#ifdef DBG_TA
    unsigned long long* stamps = (unsigned long long*)(ws + WS_CTL + 256 * 1024);
#define STAMP(k) do { if (bx == 0 && tid == 0) stamps[k] = __builtin_amdgcn_s_memrealtime(); } while (0)
#else
#define STAMP(k) do { } while (0)
#endif
    STAMP(0);
#if !MK_SPLIT && !defined(MK_CGSYNC)
#define SEAM(k) do { if (IN(k) && IN((k) + 1)) xcd_barrier(xbar); STAMP((k) + 1); } while (0)
#else
#define SEAM(k) do { if (IN(k) && IN((k) + 1)) grid.sync(); STAMP((k) + 1); } while (0)
#endif

    constexpr int I0 = 32 * 144, I1 = 32 * 64, I2 = 16 * 32, I3 = 16 * 32, I4 = 32 * 32, I5 = 32 * 32, I6 = 32 * 32, I7 = 32 * 176, I8 = 88 * 32;
    constexpr int NITA = I0 + I1, NITB = I2 + I3 + I4 + I5 + I6 + I7 + I8;
#define TRA_LOAD(it_, v_) do { int r = (it_); \
            if (r < I1) { tr_load(w_ckv, 4096, r, lane, v_); break; } r -= I1; \
            tr_load(w_in, 9216, r, lane, v_); } while (0)
#define TRA_PROC(it_, v_) do { int r = (it_); \
            if (r < I1) { tr_proc(v_, D, 4096, WCKV, 0, nullptr, scr, r, lane); break; } r -= I1; \
            tr_proc(v_, D, 9216, WIN, 1, norm_mix_g, scr, r, lane); } while (0)
#define TRB_LOAD(it_, v_) do { int r = (it_); \
            if (r < I8) { tr_load(w_ffn_out, D, r, lane, v_); break; } r -= I8; \
            if (r < I7) { tr_load(w_ffn_in, 2 * DFF, r, lane, v_); break; } r -= I7; \
            if (r < I6) { tr_load(w_co, D, r, lane, v_); break; } r -= I6; \
            if (r < I5) { tr_load(w_cq, D, r, lane, v_); break; } r -= I5; \
            if (r < I4) { tr_load(w_out, D, r, lane, v_); break; } r -= I4; \
            if (r < I3) { tr_load(w_att_out, D, r, lane, v_); break; } r -= I3; \
            tr_load(w_conv_out, D, r, lane, v_); } while (0)
#define TRB_PROC(it_, v_) do { int r = (it_); \
            if (r < I8) { tr_proc(v_, DFF, D, WFO, 0, nullptr, scr, r, lane, true); break; } r -= I8; \
            if (r < I7) { tr_proc(v_, D, 2 * DFF, WFI, 2, norm_ffn_g, scr, r, lane, true); break; } r -= I7; \
            if (r < I6) { tr_proc(v_, D, D, WCO, 0, nullptr, scr, r, lane, true); break; } r -= I6; \
            if (r < I5) { tr_proc(v_, D, D, WCQ, 0, norm_cross_g, scr, r, lane, true); break; } r -= I5; \
            if (r < I4) { tr_proc(v_, D, D, WOUT, 0, nullptr, scr, r, lane, true); break; } r -= I4; \
            if (r < I3) { tr_proc(v_, 2048, D, WCONV + 1024, 0, nullptr, scr, r, lane); break; } r -= I3; \
            tr_proc(v_, 2048, D, WCONV, 0, nullptr, scr, r, lane); } while (0)
#define TR_RUN(LOAD_, PROC_, first_, stride_, total_) do { f32x4 va[16], vb[16]; int it = (first_); \
          if (it < (total_)) LOAD_(it, va); \
          while (it < (total_)) { \
              const int n1 = it + (stride_); if (n1 < (total_)) LOAD_(n1, vb); \
              PROC_(it, va); \
              const int n2 = n1 + (stride_); if (n2 < (total_)) LOAD_(n2, va); \
              if (n1 < (total_)) PROC_(n1, vb); \
              it = n2; } } while (0)
    if (IN(0)) {
        LAS float* scr = (LAS float*)(lds + wave * 16640);
        const int gw = bx * 8 + wave, NGW = G * 8;
        TR_RUN(TRB_LOAD, TRB_PROC, gw, NGW, NITB);
        TR_RUN(TRA_LOAD, TRA_PROC, gw, NGW, NITA);
        for (int m = gw; m < T; m += NGW) xb_row(x + (size_t)m * D, Hb + (size_t)m * D, rstd0 + m, lane);
        for (int m = gw; m < MEMT; m += NGW) rms_row_bf16(mem + (size_t)m * D, norm_mem_g, MN + (size_t)m * D, lane);
        for (int i = bx * 512 + tid; i < 9216; i += G * 512) bias_p[map_win(i)] = b_in[i];
    }
    SEAM(0);
    if (IN(1)) {
        { pg8::Gemm gm{Hb, WIN, T, 8192, D}; pg8::StaticOrder S; S.init(T, 8192, G, bx);
          pg8::EpiProj E{VGLU, Qb, (WS_K - WS_Q) / 2, (WS_SG - WS_Q) / 2, bias_p, ksum, rstd0};
          pg8::gemm_phase<pg8::EpiProj, pg8::StaticOrder, true, true>(lds, gm, S, E); }
#pragma unroll 1
        for (int gi = 0; gi < 3; ++gi) {
            const size_t offA = gi == 0 ? WS_WIN + (size_t)8192 * D * 2 : (gi == 1 ? WS_MN : WS_WCKV + (size_t)2048 * D * 2);
            const size_t offB = gi == 0 ? WS_H : (gi == 1 ? WS_WCKV : WS_MN);
            const size_t offO = gi == 0 ? WS_VT : (gi == 1 ? WS_KC : WS_VCT);
            const int gM = gi == 0 ? 1024 : (gi == 1 ? MEMT : 2048), gN = gi == 0 ? T : (gi == 1 ? 2048 : MEMT), shift = gi == 0 ? 0 : (gi == 1 ? 128 : 160);
            pg8::Gemm gm{(const bf16_t*)(ws + offA), (const bf16_t*)(ws + offB), gM, gN, D};
            pg8::EpiPlain E{(bf16_t*)(ws + offO), gN, bias_p + 8192, gi == 0 ? 1 : 0, rstd0};
            pg8::StaticOrder S; S.init(gM, gN, G, (bx + G - (shift % G)) % G);
            pg8::gemm_phase<pg8::EpiPlain, pg8::StaticOrder, true, true>(lds, gm, S, E);
        }
    }
    SEAM(1);
    if (IN(2)) {
#ifdef DBG_CONV2
        for (int rep = 0; rep < DBG_CONV2; ++rep)
#endif
        { float w0[31], w1[31];
#pragma unroll
          for (int j = 0; j < 31; ++j) { const f32x2v w = *(const f32x2v*)(conv_w + j * DC + 2 * tid); w0[j] = w[0]; w1[j] = w[1]; }
          for (int t = vcu; t < T / 16; t += G) conv_unit(lds, t, VGLU, w0, w1, conv_b, conv_ln_g, conv_ln_b, YC, tid, wave, lane); }
#ifdef DBG_MOBA2
        for (int rep = 0; rep < DBG_MOBA2; ++rep)
#endif
        for (int c = vcu; c < 256; c += G) { const int bh = c >> 3, qa = c & 7;
            moba_unit(lds, bh >> 3, bh & 7, 15 - qa, Qb, Kb, VT, ksum, YA, tid, wave, lane);
            moba_unit(lds, bh >> 3, bh & 7, qa, Qb, Kb, VT, ksum, YA, tid, wave, lane); }
        __syncthreads();
    }
    SEAM(2);
    if (IN(3)) {
        pg8::Gemm gm{YC, WCONV, T, D, 2048, 1024}; pg8::HalfOrder S; S.init(T, D, G, bx); pg8::EpiGateFused E{SG, MERGED};
        pg8::gemm_phase<pg8::EpiGateFused, pg8::HalfOrder, true, true>(lds, gm, S, E);
    }
    SEAM(3);
    if (IN(4)) {
        pg8::Gemm gm{MERGED, WOUT, T, D, D}; pg8::StaticOrder S; S.init(T, D, G, bx); pg8::EpiResid<true, false, true> E{nullptr, Hb, nullptr, X1B, ssq1};
        pg8::gemm_phase<pg8::EpiResid<true, false, true>, pg8::StaticOrder, true, true>(lds, gm, S, E);
    }
    SEAM(4);
    if (IN(5)) {
#ifdef DBG_ZERO_OC
        for (size_t i = (size_t)bx * 512 + tid; i < (size_t)T * D / 8; i += (size_t)G * 512) ((u32x4*)OC)[i] = (u32x4){0u, 0u, 0u, 0u};
#endif
        pg8::Gemm gm{X1B, WCQ, T, D, D}; pg8::StaticOrder S; S.init(T, D, G, bx); pg8::EpiRowScale E{QC, ssq1, 0.04419417382415922f};
        pg8::gemm_phase<pg8::EpiRowScale, pg8::StaticOrder, true, true>(lds, gm, S, E);
    }
    SEAM(5);
    if (IN(6)) {
        for (int c = vcu; c < 256; c += G) cross_unit(lds, c >> 6, (c >> 4) & 3, c & 15, QC, KC, VCT, OC, tid, wave, lane);
        __syncthreads();
    }
    SEAM(6);
    if (IN(7)) {
        pg8::Gemm gm{OC, WCO, T, D, D}; pg8::StaticOrder S; S.init(T, D, G, bx); pg8::EpiResid<true, false, true> E{nullptr, X1B, nullptr, X2B, ssq2};
        pg8::gemm_phase<pg8::EpiResid<true, false, true>, pg8::StaticOrder, true, true>(lds, gm, S, E);
    }
    SEAM(7);
    if (IN(8)) {
        pg8::Gemm gm{X2B, WFI, T, 2 * DFF, D}; pg8::StaticOrder S; S.init(T, 2 * DFF, G, bx); pg8::EpiSwiglu E{ACT, ssq2};
        pg8::gemm_phase<pg8::EpiSwiglu, pg8::StaticOrder, true, true>(lds, gm, S, E);
    }
    SEAM(8);
    const bool fuse_final = (G == 256) && IN(9) && IN(10);
    if (IN(9)) {
        pg8::Gemm gm{ACT, WFO, T, D, DFF}; pg8::StaticOrder S; S.init(T, D, G, bx);
        if (fuse_final) { pg8::EpiFinal E{X2B, out, ssq3, (unsigned*)(ws + WS_CTL + 784 * 1024), norm_final_g};
            pg8::gemm_phase<pg8::EpiFinal, pg8::StaticOrder, true, true>(lds, gm, S, E); }
        else { pg8::EpiResid<true, true, false> E{nullptr, X2B, out, nullptr, ssq3};
            pg8::gemm_phase<pg8::EpiResid<true, true, false>, pg8::StaticOrder, true, true>(lds, gm, S, E); }
    }
    if (!fuse_final) {
    SEAM(9);
    if (IN(10)) {
        const int gw = bx * 8 + wave, NGW = G * 8;
        for (int m = gw; m < T; m += NGW) { const float rs = rsqrtf(wave_sum(lane < 32 ? ssq3[(size_t)m * 32 + lane] : 0.f) * (1.0f / 2048.0f) + EPS); f32x4* xr = (f32x4*)(out + (size_t)m * D) + lane;
#pragma unroll
            for (int j = 0; j < 8; ++j) { const f32x4 gg = ((const f32x4*)norm_final_g)[64 * j + lane]; xr[64 * j] = xr[64 * j] * rs * gg; } }
    }
    }
#ifdef DBG_TA
    STAMP(11);
    grid.sync();
    { const float va = (float)(stamps[DBG_TA + 1] - stamps[DBG_TA]) * 0.01f, vb = (float)(stamps[DBG_TB + 1] - stamps[DBG_TB]) * 0.01f;
      if (bx == 0 && tid == 0) out[0] = va;
      for (size_t i = (size_t)(1u << 20) + (size_t)bx * 512 + tid; i < (size_t)(2u << 20); i += (size_t)G * 512) out[i] += vb; }
#endif
#undef IN
#undef SEAM
}


#ifdef DBG_STOP
__device__ __forceinline__ float dsan(unsigned short b) { float v = __uint_as_float(((unsigned)b) << 16); return (v == v && fabsf(v) < 1e30f) ? v : 1000.0f; }
__global__ void dbg_copy(unsigned char* ws, float* out) {
    const bf16_t* Qb = (const bf16_t*)(ws + WS_Q); const bf16_t* Kb = (const bf16_t*)(ws + WS_K); const bf16_t* VT = (const bf16_t*)(ws + WS_VT); const bf16_t* VG = (const bf16_t*)(ws + WS_VGLU);
    const bf16_t* SG = (const bf16_t*)(ws + WS_SG); const bf16_t* KC = (const bf16_t*)(ws + WS_KC); const bf16_t* VCT = (const bf16_t*)(ws + WS_VCT);
    const bf16_t* YC = (const bf16_t*)(ws + WS_YC); const bf16_t* YA = (const bf16_t*)(ws + WS_YA); const bf16_t* MG = (const bf16_t*)(ws + WS_MERGED);
    const bf16_t* QC = (const bf16_t*)(ws + WS_QC); const bf16_t* OC = (const bf16_t*)(ws + WS_OC); const bf16_t* ACT = (const bf16_t*)(ws + WS_ACT);
    const size_t M8 = (size_t)8 << 20, M2 = (size_t)2 << 20, M16 = (size_t)16 << 20;
    for (size_t i = (size_t)blockIdx.x * blockDim.x + threadIdx.x; i < M16; i += (size_t)gridDim.x * blockDim.x) {
        float v = 0.f;
        if (DBG_SET == 1) v = dsan(Qb[i % M8]) + dsan(Kb[i % M8]) + dsan(VT[i % M8]) + dsan(VG[i % M8]) + dsan(SG[i]) + dsan(SG[i + M16]) + dsan(KC[i % M2]) + dsan(VCT[i % M2]);
        if (DBG_SET == 2) v = dsan(YC[i % M8]) + dsan(YA[i % M8]);
        if (DBG_SET == 3) v = dsan(MG[i]);
        if (DBG_SET == 4) { const float o = out[i]; v = (o == o && fabsf(o) < 1e30f) ? o : 1000.0f; }
        if (DBG_SET == 5) v = dsan(QC[i]);
        if (DBG_SET == 6) v = dsan(OC[i]);
        if (DBG_SET == 8) v = dsan(ACT[i]) + dsan(ACT[i + M16]);
        if (DBG_SET == 60) { const float t = __uint_as_float(((unsigned)OC[i]) << 16); v = (t == t && fabsf(t) < 100.f) ? 0.f : 1000.f; }
        if (DBG_SET == 30) v = dsan(KC[i % M2]);
        if (DBG_SET == 31) v = dsan(VCT[i % M2]);
        if (DBG_SET == 20) v = dsan(YC[i % M8]);
        if (DBG_SET == 21) v = dsan(YA[i % M8]);
        out[i] = v;
    }
}
#endif
extern "C" void kernel_launch(void* const* d_in, const int* in_sizes, int n_in, void* d_out, int out_size, void* d_ws, size_t ws_size, hipStream_t stream) {
    static int grid = 0;
    if (grid == 0) {
        int dev = 0, cus = 0, per_cu = 0;
        if (n_in != 21 || ws_size < WS_END) { fprintf(stderr, "kernel_launch: n_in %d ws_size %zu (need %zu)\n", n_in, ws_size, (size_t)WS_END); grid = -1; return; }
        (void)hipGetDevice(&dev); (void)hipDeviceGetAttribute(&cus, hipDeviceAttributeMultiprocessorCount, dev);
        if (hipFuncSetAttribute((const void*)fwd, hipFuncAttributeMaxDynamicSharedMemorySize, LDS_BYTES) != hipSuccess) { fprintf(stderr, "kernel_launch: hipFuncSetAttribute failed\n"); grid = -1; return; }
        if (hipOccupancyMaxActiveBlocksPerMultiprocessor(&per_cu, (const void*)fwd, 512, LDS_BYTES) != hipSuccess || per_cu < 1) { fprintf(stderr, "kernel_launch: occupancy query gave %d\n", per_cu); per_cu = 1; }
        (void)hipGetLastError();
        grid = cus * per_cu;
        fprintf(stderr, "kernel_launch: grid %d (%d CUs x %d), ws %zu\n", grid, cus, per_cu, ws_size);
    }
    if (grid < 0) return;
    Args a{};
    for (int i = 0; i < 21; ++i) a.in[i] = (const float*)d_in[i];
    a.out = (float*)d_out; a.ws = (unsigned char*)d_ws;
#if MK_SPLIT
#ifdef DBG_STOP
    for (int ph = 0; ph < DBG_STOP; ++ph) { a.lo = ph; a.hi = ph + 1; hipLaunchKernelGGL(fwd, dim3(grid), dim3(512), LDS_BYTES, stream, a); }
    hipLaunchKernelGGL(dbg_copy, dim3(2048), dim3(256), 0, stream, (unsigned char*)d_ws, (float*)d_out);
#else
    for (int ph = 0; ph < NPHASE; ++ph) { a.lo = ph; a.hi = ph + 1; hipLaunchKernelGGL(fwd, dim3(grid), dim3(512), LDS_BYTES, stream, a);
#ifdef DBG_DOUBLE
        if (ph == DBG_DOUBLE) hipLaunchKernelGGL(fwd, dim3(grid), dim3(512), LDS_BYTES, stream, a);
#endif
    }
#endif
#else
    a.lo = 0; a.hi = NPHASE;
    void* args[] = {&a};
    hipError_t e = hipLaunchCooperativeKernel((const void*)fwd, dim3(grid), dim3(512), args, LDS_BYTES, stream);
    if (e != hipSuccess) fprintf(stderr, "cooperative launch failed: %s (grid %d)\n", hipGetErrorString(e), grid);
#endif
}
```
